# Optimizing an MI355X kernel written in HIP

```python
import math
import jax, jax.numpy as jnp
from jax import lax
import numpy as np

D_MODEL = 1024
BATCH = 16
SEQ = 4096
DEPTH = 1

D_MIX = D_MODEL
D_MLSTM = D_MIX // 2
D_SSM = D_MIX - D_MLSTM
MLSTM_HEADS = 4
MLSTM_DV = D_MLSTM // MLSTM_HEADS
MLSTM_DQK = MLSTM_DV // 2
MLSTM_CHUNK = 128
QK_CONV = 5
SSM_GROUP = 16
SSM_GROUPS = D_SSM // SSM_GROUP
SSM_STATE = 64
D_FF = 2816
N_SUB = 3
DEEP_ALPHA = (2.0 * DEPTH) ** 0.25
DEEP_BETA = (8.0 * DEPTH) ** -0.25
LN_EPS = 1e-5
F_BIAS_LO = 3.0
F_BIAS_HI = 6.0
LOG_STEP_MIN = math.log(1e-3)
LOG_STEP_MAX = math.log(1e-1)

Q_COLS = MLSTM_HEADS * MLSTM_DQK
K_COLS = MLSTM_HEADS * MLSTM_DQK
V_COLS = D_MLSTM
O_COLS = D_MLSTM
IG_COLS = 2 * MLSTM_HEADS
FG_COLS = 2 * MLSTM_HEADS
U_COLS = D_SSM
SPLIT_POINTS = (Q_COLS, Q_COLS + K_COLS, Q_COLS + K_COLS + V_COLS,
                Q_COLS + K_COLS + V_COLS + O_COLS,
                Q_COLS + K_COLS + V_COLS + O_COLS + IG_COLS,
                Q_COLS + K_COLS + V_COLS + O_COLS + IG_COLS + FG_COLS)
FG_OFFSET = Q_COLS + K_COLS + V_COLS + O_COLS + IG_COLS
IN_COLS = Q_COLS + K_COLS + V_COLS + O_COLS + IG_COLS + FG_COLS + U_COLS

kernel_name = "hymba_mlstm_s5_macaron_deepnorm_adaln"


def _layer_norm(x, g, b):
    xf = x.astype(jnp.float32)
    mu = jnp.mean(xf, axis=-1, keepdims=True)
    var = jnp.mean(jnp.square(xf - mu), axis=-1, keepdims=True)
    return ((xf - mu) * lax.rsqrt(var + LN_EPS) * g + b).astype(x.dtype)


def _rms_norm(x, g):
    xf = x.astype(jnp.float32)
    return xf * lax.rsqrt(jnp.mean(jnp.square(xf), axis=-1, keepdims=True) + LN_EPS) * g


def _modulate(x, shift, scale):
    return x * (1.0 + scale[:, None, :]) + shift[:, None, :]


def _post_norm(x, f_out, gate, g, b):
    return _layer_norm(DEEP_ALPHA * x + (1.0 + gate[:, None, :]) * f_out, g, b)


def _swiglu(h, w_up, w_down):
    gate, up = jnp.split(h @ w_up, 2, axis=-1)
    return (jax.nn.silu(gate) * up) @ w_down


def _centred_dwconv(x, w, b):
    ch = x.shape[-1]
    y = lax.conv_general_dilated(
        x, w[:, None, :].astype(x.dtype), window_strides=(1,),
        padding=[(QK_CONV // 2, QK_CONV // 2)],
        dimension_numbers=('NWC', 'WIO', 'NWC'), feature_group_count=ch)
    return y + b


def _mlstm_chunkwise(q, k, v, i_pre, f_pre):
    bsz, nh, s_len, dqk = q.shape
    dv = v.shape[-1]
    nc = s_len // MLSTM_CHUNK

    def chunks(t):
        t = t.reshape((bsz, nh, nc, MLSTM_CHUNK) + t.shape[3:])
        return jnp.moveaxis(t, 2, 0)

    xs = (chunks(q), chunks(k), chunks(v), chunks(i_pre), chunks(jax.nn.log_sigmoid(f_pre)))
    lower = jnp.tril(jnp.ones((MLSTM_CHUNK, MLSTM_CHUNK), dtype=bool))

    def step(carry, inp):
        c_mem, n_mem, m_mem = carry
        q_c, k_c, v_c, i_c, lf_c = inp
        b_cum = jnp.cumsum(lf_c, axis=-1)
        d_log = b_cum[..., :, None] - b_cum[..., None, :] + i_c[..., None, :]
        d_log = jnp.where(lower, d_log, -jnp.inf)
        inter = b_cum + m_mem[..., None]
        m_t = jnp.maximum(inter, jnp.max(d_log, axis=-1))
        w_intra = jnp.exp(d_log - m_t[..., None])
        w_inter = jnp.exp(inter - m_t)
        scores = jnp.einsum('bhtd,bhsd->bhts', q_c, k_c) * w_intra
        num = (jnp.einsum('bhts,bhsv->bhtv', scores, v_c)
               + w_inter[..., None] * jnp.einsum('bhtd,bhdv->bhtv', q_c, c_mem))
        den = jnp.sum(scores, axis=-1) + w_inter * jnp.einsum('bhtd,bhd->bht', q_c, n_mem)
        h = num / jnp.maximum(jnp.abs(den), jnp.exp(-m_t))[..., None]
        b_end = b_cum[..., -1]
        g_log = b_end[..., None] - b_cum + i_c
        m_new = jnp.maximum(b_end + m_mem, jnp.max(g_log, axis=-1))
        w_state = jnp.exp(g_log - m_new[..., None])
        decay = jnp.exp(b_end + m_mem - m_new)
        c_new = decay[..., None, None] * c_mem + jnp.einsum('bhs,bhsd,bhsv->bhdv', w_state, k_c, v_c)
        n_new = decay[..., None] * n_mem + jnp.einsum('bhs,bhsd->bhd', w_state, k_c)
        return (c_new, n_new, m_new), h

    init = (jnp.zeros((bsz, nh, dqk, dv), jnp.float32),
            jnp.zeros((bsz, nh, dqk), jnp.float32),
            jnp.zeros((bsz, nh), jnp.float32))
    _, h_chunks = lax.scan(step, init, xs)
    return jnp.moveaxis(h_chunks, 0, 2).reshape(bsz, nh, s_len, dv)


def _complex_linear_combine(left, right):
    a1r, a1i, b1r, b1i = left
    a2r, a2i, b2r, b2i = right
    return (a2r * a1r - a2i * a1i, a2r * a1i + a2i * a1r,
            a2r * b1r - a2i * b1i + b2r, a2r * b1i + a2i * b1r + b2i)


def _s5_bidir(u, lam_re, lam_im, log_step, b_re, b_im, c_re, c_im, d_skip):
    bsz, s_len, _ = u.shape
    uf = u.astype(jnp.float32)
    ug = uf.reshape(bsz, s_len, SSM_GROUPS, SSM_GROUP)
    bu_re = jnp.einsum('bsgh,gph->bsgp', ug, b_re)
    bu_im = jnp.einsum('bsgh,gph->bsgp', ug, b_im)
    y = d_skip * uf
    for direction, reverse in ((0, False), (1, True)):
        lr, li = lam_re[direction], lam_im[direction]
        step = jnp.exp(log_step[direction])[:, None]
        mag = jnp.exp(lr * step)
        ab_re, ab_im = mag * jnp.cos(li * step), mag * jnp.sin(li * step)
        nr, ni = ab_re - 1.0, ab_im
        inv = 1.0 / (lr * lr + li * li)
        cf_re = (nr * lr + ni * li) * inv
        cf_im = (ni * lr - nr * li) * inv
        x_re = cf_re * bu_re - cf_im * bu_im
        x_im = cf_re * bu_im + cf_im * bu_re
        a_re = jnp.broadcast_to(ab_re, (1, s_len) + ab_re.shape)
        a_im = jnp.broadcast_to(ab_im, (1, s_len) + ab_im.shape)
        _, _, h_re, h_im = lax.associative_scan(
            _complex_linear_combine, (a_re, a_im, x_re, x_im), axis=1, reverse=reverse)
        y_dir = (jnp.einsum('bsgp,ghp->bsgh', h_re, c_re[direction])
                 - jnp.einsum('bsgp,ghp->bsgh', h_im, c_im[direction]))
        y = y + y_dir.reshape(bsz, s_len, D_SSM)
    return y


def _token_mixer(u, w_in, b_in, qk_conv_w, qk_conv_b, mlstm_norm_g, ssm_lam_re, ssm_lam_im,
                 ssm_log_step, ssm_b_re, ssm_b_im, ssm_c_re, ssm_c_im, ssm_d, ssm_glu_w,
                 ssm_glu_b, ssm_norm_g, w_out):
    bsz, s_len, _ = u.shape
    proj = u @ w_in + b_in
    q, k, v, o, ig, fg, us = jnp.split(proj, SPLIT_POINTS, axis=-1)
    qk = jax.nn.silu(_centred_dwconv(jnp.concatenate([q, k], axis=-1), qk_conv_w, qk_conv_b))
    q, k = jnp.split(qk, 2, axis=-1)

    def heads(t):
        return t.reshape(bsz, s_len, MLSTM_HEADS, -1).transpose(0, 2, 1, 3).astype(jnp.float32)

    def gates(t):
        return t.astype(jnp.float32).reshape(bsz, s_len, 2, MLSTM_HEADS).transpose(2, 0, 3, 1)

    qh, kh, vh = heads(q), heads(k) * (MLSTM_DQK ** -0.5), heads(v)
    igs, fgs = gates(ig), gates(fg)
    flip = lambda t: jnp.flip(t, axis=2)
    cell = (_mlstm_chunkwise(qh, kh, vh, igs[0], fgs[0])
            + flip(_mlstm_chunkwise(flip(qh), flip(kh), flip(vh), flip(igs[1]), flip(fgs[1]))))
    h = jax.nn.sigmoid(heads(o)) * cell
    mu = jnp.mean(h, axis=-1, keepdims=True)
    var = jnp.mean(jnp.square(h - mu), axis=-1, keepdims=True)
    h = (h - mu) * lax.rsqrt(var + LN_EPS) * mlstm_norm_g.reshape(MLSTM_HEADS, 1, MLSTM_DV)
    h_mlstm = h.transpose(0, 2, 1, 3).reshape(bsz, s_len, D_MLSTM)

    y = _s5_bidir(us, ssm_lam_re, ssm_lam_im, ssm_log_step, ssm_b_re, ssm_b_im,
                  ssm_c_re, ssm_c_im, ssm_d)
    y = jax.nn.gelu(y)
    y = y * jax.nn.sigmoid(y @ ssm_glu_w + ssm_glu_b)
    y = _rms_norm(y, ssm_norm_g)
    mixed = jnp.concatenate([h_mlstm, y], axis=-1).astype(u.dtype)
    return mixed @ w_out


def setup_inputs(seed: int = 0) -> dict:
    key = jax.random.key(seed)
    ks = jax.random.split(key, 32)
    L = DEPTH
    nrm = lambda k, shape, s: jax.random.normal(k, shape, jnp.float32) * s
    gain = lambda k, shape: 1.0 + nrm(k, shape, 0.01)
    b_in = nrm(ks[9], (L, IN_COLS), 0.02)
    f_bias = jnp.tile(jnp.linspace(F_BIAS_LO, F_BIAS_HI, MLSTM_HEADS), 2)
    b_in = b_in.at[:, FG_OFFSET:FG_OFFSET + FG_COLS].add(f_bias)
    lam_im0 = math.pi * jnp.arange(SSM_STATE, dtype=jnp.float32)
    return {
        "x": nrm(ks[0], (BATCH, SEQ, D_MODEL), 1.0),
        "c": nrm(ks[1], (BATCH, D_MODEL), 1.0),
        "w_ada": nrm(ks[2], (L, D_MODEL, N_SUB * 3 * D_MODEL), 0.5 * D_MODEL ** -0.5),
        "b_ada": nrm(ks[3], (L, N_SUB * 3 * D_MODEL), 0.02),
        "ffn1_w_up": nrm(ks[4], (L, D_MODEL, 2 * D_FF), D_MODEL ** -0.5),
        "ffn1_w_down": nrm(ks[5], (L, D_FF, D_MODEL), DEEP_BETA * D_FF ** -0.5),
        "ln1_g": gain(ks[6], (L, D_MODEL)),
        "ln1_b": nrm(ks[7], (L, D_MODEL), 0.01),
        "w_in": nrm(ks[8], (L, D_MODEL, IN_COLS), D_MODEL ** -0.5),
        "b_in": b_in,
        "qk_conv_w": nrm(ks[10], (L, QK_CONV, Q_COLS + K_COLS), QK_CONV ** -0.5),
        "qk_conv_b": nrm(ks[11], (L, Q_COLS + K_COLS), 0.01),
        "mlstm_norm_g": gain(ks[12], (L, D_MLSTM)),
        "ssm_lam_re": -0.5 + nrm(ks[13], (L, 2, SSM_GROUPS, SSM_STATE), 0.01),
        "ssm_lam_im": lam_im0 + nrm(ks[14], (L, 2, SSM_GROUPS, SSM_STATE), 0.01),
        "ssm_log_step": jax.random.uniform(ks[15], (L, 2, SSM_GROUPS), jnp.float32,
                                           LOG_STEP_MIN, LOG_STEP_MAX),
        "ssm_b_re": nrm(ks[16], (L, SSM_GROUPS, SSM_STATE, SSM_GROUP), (2 * SSM_GROUP) ** -0.5),
        "ssm_b_im": nrm(ks[17], (L, SSM_GROUPS, SSM_STATE, SSM_GROUP), (2 * SSM_GROUP) ** -0.5),
        "ssm_c_re": nrm(ks[18], (L, 2, SSM_GROUPS, SSM_GROUP, SSM_STATE), 0.5),
        "ssm_c_im": nrm(ks[19], (L, 2, SSM_GROUPS, SSM_GROUP, SSM_STATE), 0.5),
        "ssm_d": nrm(ks[20], (L, D_SSM), 1.0),
        "ssm_glu_w": nrm(ks[21], (L, D_SSM, D_SSM), D_SSM ** -0.5),
        "ssm_glu_b": nrm(ks[22], (L, D_SSM), 0.01),
        "ssm_norm_g": gain(ks[23], (L, D_SSM)),
        "w_out": nrm(ks[24], (L, D_MIX, D_MODEL), DEEP_BETA * D_MIX ** -0.5),
        "ln2_g": gain(ks[25], (L, D_MODEL)),
        "ln2_b": nrm(ks[26], (L, D_MODEL), 0.01),
        "ffn2_w_up": nrm(ks[27], (L, D_MODEL, 2 * D_FF), D_MODEL ** -0.5),
        "ffn2_w_down": nrm(ks[28], (L, D_FF, D_MODEL), DEEP_BETA * D_FF ** -0.5),
        "ln3_g": gain(ks[29], (L, D_MODEL)),
        "ln3_b": nrm(ks[30], (L, D_MODEL), 0.01),
    }


def reference(x, c, w_ada, b_ada, ffn1_w_up, ffn1_w_down, ln1_g, ln1_b, w_in, b_in,
              qk_conv_w, qk_conv_b, mlstm_norm_g, ssm_lam_re, ssm_lam_im, ssm_log_step,
              ssm_b_re, ssm_b_im, ssm_c_re, ssm_c_im, ssm_d, ssm_glu_w, ssm_glu_b,
              ssm_norm_g, w_out, ln2_g, ln2_b, ffn2_w_up, ffn2_w_down, ln3_g, ln3_b):
    bsz = x.shape[0]
    c_act = jax.nn.silu(c)
    for l in range(DEPTH):
        mod = (c_act @ w_ada[l] + b_ada[l]).reshape(bsz, N_SUB, 3, D_MODEL)
        f1 = _swiglu(_modulate(x, mod[:, 0, 0], mod[:, 0, 1]), ffn1_w_up[l], ffn1_w_down[l])
        x = _post_norm(x, 0.5 * f1, mod[:, 0, 2], ln1_g[l], ln1_b[l])
        tm = _token_mixer(_modulate(x, mod[:, 1, 0], mod[:, 1, 1]), w_in[l], b_in[l],
                          qk_conv_w[l], qk_conv_b[l], mlstm_norm_g[l], ssm_lam_re[l],
                          ssm_lam_im[l], ssm_log_step[l], ssm_b_re[l], ssm_b_im[l],
                          ssm_c_re[l], ssm_c_im[l], ssm_d[l], ssm_glu_w[l], ssm_glu_b[l],
                          ssm_norm_g[l], w_out[l])
        x = _post_norm(x, tm, mod[:, 1, 2], ln2_g[l], ln2_b[l])
        f2 = _swiglu(_modulate(x, mod[:, 2, 0], mod[:, 2, 1]), ffn2_w_up[l], ffn2_w_down[l])
        x = _post_norm(x, 0.5 * f2, mod[:, 2, 2], ln3_g[l], ln3_b[l])
    return x
```

```cpp
#include <hip/hip_runtime.h>
#include <hip/hip_cooperative_groups.h>
#include <cstdio>
namespace cg = cooperative_groups;

#define LAS __attribute__((address_space(3)))
typedef unsigned short bf16_t;
typedef short bf16x8 __attribute__((ext_vector_type(8)));
typedef float f32x4 __attribute__((ext_vector_type(4)));
typedef float f32x16 __attribute__((ext_vector_type(16)));
typedef unsigned u32x4 __attribute__((ext_vector_type(4)));
typedef unsigned u32x2 __attribute__((ext_vector_type(2)));

constexpr int NB = 16, SEQ = 4096, DM = 1024, MTOK = NB * SEQ, DFF = 2816, NUP = 2 * DFF;
constexpr int NIN = 2064, NINP = 2304;
constexpr int MODW = 9216;
constexpr float ALPHA = 1.189207115002721f;
constexpr float LN_EPS = 1e-5f;
constexpr int SL = 32;
constexpr int SNROW = MTOK / SL, SNCH = SEQ / SL, UK = SL * 16;
constexpr int UEXT = UK + 256;
constexpr int LDS_BYTES = 147456;
constexpr int NPHASE = 17;

constexpr size_t MiB = 1u << 20;
constexpr size_t WS_MODP = 278 * MiB  , WS_MOD = 5 * MiB, WS_BIN = 6 * MiB, WS_BAR = 7 * MiB, BAR_BYTES = 32768;
constexpr size_t WS_WUP1 = 8 * MiB, WS_WDN1 = 19 * MiB, WS_WUP2 = 25 * MiB, WS_WDN2 = 36 * MiB;
constexpr size_t WS_WIN = 42 * MiB, WS_WOUT = 47 * MiB, WS_WGLU = 49 * MiB;
constexpr size_t WS_KTAB = 50 * MiB, WS_BT1 = 54 * MiB, WS_BT2 = 70 * MiB;
constexpr size_t WS_XM = 150 * MiB, WS_H = 278 * MiB;
constexpr size_t WS_QKR = 630 * MiB, WS_V = 694 * MiB, WS_OG = 758 * MiB, WS_QKC = 822 * MiB, WS_GATES = 886 * MiB, WS_UEXT = 890 * MiB;
constexpr size_t WS_HF = 278 * MiB, WS_HB = 342 * MiB, WS_SLOC = 406 * MiB  , WS_YACT = 470 * MiB, WS_Z = 534 * MiB;
constexpr size_t WS_STAT1 = 0, WS_STAT2 = 1 * MiB;
constexpr size_t WS_Y3 = 630 * MiB;
constexpr size_t WS_END = 986 * MiB;
static_assert(WS_V == WS_QKR + 64 * MiB && WS_OG == WS_V + 64 * MiB, "q|k, v, o buffers 64 MiB apart");

typedef __bf16 bf16x2n __attribute__((ext_vector_type(2)));
typedef float f32x2n __attribute__((ext_vector_type(2)));
__device__ __forceinline__ unsigned cvt_pk_bf16(float lo, float hi) { const f32x2n v = {lo, hi}; const bf16x2n b = __builtin_convertvector(v, bf16x2n); return __builtin_bit_cast(unsigned, b); }
__device__ __forceinline__ bf16_t f2bf(float f) { const __bf16 b = (__bf16)f; return __builtin_bit_cast(bf16_t, b); }
__device__ __forceinline__ float bf2f(unsigned b) { return __builtin_bit_cast(float, b << 16); }
__device__ __forceinline__ float bflo(unsigned w) { return __builtin_bit_cast(float, w << 16); }
__device__ __forceinline__ float bfhi(unsigned w) { return __builtin_bit_cast(float, w & 0xffff0000u); }
__device__ __forceinline__ float sigmoidf_(float x) { return __builtin_amdgcn_rcpf(1.0f + __builtin_amdgcn_exp2f(-1.4426950408889634f * x)); }
__device__ __forceinline__ float siluf_(float x) { return x * __builtin_amdgcn_rcpf(1.0f + __builtin_amdgcn_exp2f(-1.4426950408889634f * x)); }
__device__ __forceinline__ float gelu_tanh(float x) { const float u = -2.302208198480f * (x + 0.044715f * x * x * x); return x * __builtin_amdgcn_rcpf(1.0f + __builtin_amdgcn_exp2f(u)); }
__device__ __forceinline__ float wave_sum(float v) {
#pragma unroll
    for (int o = 1; o < 64; o <<= 1) v += __shfl_xor(v, o);
    return v;
}
__device__ __forceinline__ void cpow(float lr, float li, float step, int n, float& re, float& im) {
    const float mag = __expf((float)n * lr * step);
    const double th = (double)li * (double)step * (double)n;
    const double k = rint(th * 0.15915494309189535);
    const float r = (float)(th - k * 6.283185307179586);
    re = mag * __cosf(r); im = mag * __sinf(r);
}

namespace pg8 {
constexpr int BM = 256, BK = 64, HALF = 128, HTB = HALF * BK * 2, STAGE_BYTES = 8 * HTB, NXCD = 8, WGM = 8;
__device__ __forceinline__ int lds_byte(int r, int c) { const int st = (r >> 4) * 2 + (c >> 5), rr = r & 15, cc = c & 31, ob = rr * 64 + cc * 2; return st * 1024 + (ob ^ (((ob >> 9) & 1) << 5)); }
__device__ __forceinline__ void stage_rc(int b, int& R, int& C) { const int st = b / 1024, sb = b % 1024, swz = sb ^ (((sb >> 9) & 1) << 5); R = (st >> 1) * 16 + swz / 64; C = (st & 1) * 32 + (swz % 64) / 2; }
__device__ __forceinline__ int perm32(int rho) { const int n = rho >> 4, i = rho & 15; return 8 * (i >> 2) + 4 * n + (i & 3); }

struct Unit { int pm, pn; };
struct Gemm { const bf16_t* A; const bf16_t* Bt; int M, N, K, lda, ldb, mt_per_group; size_t bgroup_bytes; };

struct StaticOrder {
    int nM, nN, nwg, G, c;
    __device__ void init(int M, int N, int G_, int c_) { nM = M / BM; nN = N / BM; nwg = nM * nN; G = G_; c = c_; }
    __device__ bool next(int i, Unit& u) const {
        const long L = (long)i * G + c; if (L >= nwg) return false;
        int wgid = (int)L; { const int q = nwg / NXCD, r = nwg % NXCD, xcd = wgid % NXCD, off = wgid / NXCD; wgid = (xcd < r ? xcd * (q + 1) : r * (q + 1) + (xcd - r) * q) + off; }
        const int nig = WGM * nN, gid = wgid / nig, fm = gid * WGM, gsz = (nM - fm) < WGM ? (nM - fm) : WGM;
        u.pm = fm + ((wgid % nig) % gsz); u.pn = (wgid % nig) / gsz; return true;
    }
};

template <class Epi>
__device__ __forceinline__ void gemm_phase(LAS unsigned char* lds, const Gemm g, const StaticOrder& S, const Epi& E) {
    const int tid = threadIdx.x, wid = __builtin_amdgcn_readfirstlane(tid >> 6), lane = tid & 63, wr = wid >> 2, wc = wid & 3, fr = lane & 15, fq = lane >> 4;
    const int K = g.K, nt = K / BK;
    unsigned voffA[2], voffB[2];
#pragma unroll
    for (int i = 0; i < 2; ++i) { int R, C; stage_rc(tid * 16 + i * 8192, R, C); const int Rb = Epi::PERM ? ((R & ~31) + perm32(R & 31)) : R;
        voffA[i] = (unsigned)(R * g.lda + C) * 2u; voffB[i] = (unsigned)(Rb * g.ldb + C) * 2u; }
    const size_t kstep = (size_t)(BK * 2);
    const size_t hstepA = (size_t)HALF * g.lda * 2, hstepB = (size_t)HALF * g.ldb * 2;
    const size_t tstepA = 2 * hstepA, tstepB = 2 * hstepB;
    const unsigned ldsw = (unsigned)wid * 1024u;
    const int aoff = lds_byte(wr * 64 + fr, fq * 8), boff = lds_byte(wc * 32 + fr, fq * 8);
#define PG8_SA(b, h) (((b) * 2 + (h)) * HTB)
#define PG8_SB(b, h) ((4 + (b) * 2 + (h)) * HTB)
#define PG8_STAGE(bufoff, gbase, voff) do { _Pragma("unroll") for (int _i = 0; _i < 2; ++_i) \
        __builtin_amdgcn_global_load_lds((const unsigned*)((const char*)(gbase) + (voff)[_i]), (LAS unsigned*)(lds + (bufoff) + ldsw + _i * 8192), 16, 0, 0); } while (0)
#define PG8_LDA(dst, b, h) do { _Pragma("unroll") for (int m = 0; m < 4; ++m) _Pragma("unroll") for (int k = 0; k < 2; ++k) dst[m][k] = *(const LAS bf16x8*)(lds + PG8_SA(b, h) + aoff + m * 2048 + k * 1024); } while (0)
#define PG8_LDB(dst, b, h) do { _Pragma("unroll") for (int n = 0; n < 2; ++n) _Pragma("unroll") for (int k = 0; k < 2; ++k) dst[n][k] = *(const LAS bf16x8*)(lds + PG8_SB(b, h) + boff + n * 2048 + k * 1024); } while (0)
#define PG8_MMA(ai, bj, At, Bt) do { __builtin_amdgcn_s_setprio(1); _Pragma("unroll") for (int m = 0; m < 4; ++m) _Pragma("unroll") for (int n = 0; n < 2; ++n) _Pragma("unroll") for (int k = 0; k < 2; ++k) \
        acc[ai][bj][m][n] = __builtin_amdgcn_mfma_f32_16x16x32_bf16(Bt[n][k], At[m][k], acc[ai][bj][m][n], 0, 0, 0); __builtin_amdgcn_s_setprio(0); } while (0)
#define PG8_WAIT_V(n) asm volatile("s_waitcnt vmcnt(" #n ")" ::: "memory")
#define PG8_WAIT_L(n) asm volatile("s_waitcnt lgkmcnt(" #n ")" ::: "memory")
#define PG8_BAR __builtin_amdgcn_s_barrier()
#define PG8_SCHED __builtin_amdgcn_sched_barrier(0)
    Unit cur, nxt; int ui = 0;
    if (!S.next(0, cur)) return;
    f32x4 acc[2][2][4][2];
#pragma unroll
    for (int a = 0; a < 2; ++a)
#pragma unroll
        for (int b = 0; b < 2; ++b)
#pragma unroll
            for (int m = 0; m < 4; ++m)
#pragma unroll
                for (int n = 0; n < 2; ++n) acc[a][b][m][n] = (f32x4){0.f, 0.f, 0.f, 0.f};
    bf16x8 At[4][2], B0[2][2], B1[2][2];
    const char* cA = (const char*)g.A + (size_t)cur.pm * tstepA;
    const char* cB = (const char*)g.Bt + (size_t)(cur.pm / g.mt_per_group) * g.bgroup_bytes + (size_t)cur.pn * tstepB;
    PG8_STAGE(PG8_SB(0, 0), cB, voffB); PG8_STAGE(PG8_SB(0, 1), cB + hstepB, voffB); PG8_STAGE(PG8_SA(0, 0), cA, voffA); PG8_STAGE(PG8_SA(0, 1), cA + hstepA, voffA);
    if (wr == 1) PG8_BAR;
    PG8_WAIT_V(2); PG8_BAR;
    PG8_STAGE(PG8_SB(1, 0), cB + kstep, voffB); PG8_STAGE(PG8_SA(1, 0), cA + kstep, voffA); PG8_STAGE(PG8_SB(1, 1), cB + hstepB + kstep, voffB);
    PG8_WAIT_V(6); PG8_BAR;
    for (;;) {
        const bool has_next = S.next(ui + 1, nxt);
        const char* nA = has_next ? (const char*)g.A + (size_t)nxt.pm * tstepA : cA;
        const char* nB = has_next ? (const char*)g.Bt + (size_t)(nxt.pm / g.mt_per_group) * g.bgroup_bytes + (size_t)nxt.pn * tstepB : cB;
        for (int t = 0; t < nt; t += 2) {
            const bool last = (t == nt - 2);
            const char* a1 = cA + (size_t)(t + 1) * kstep;
            const char* a2 = last ? nA : cA + (size_t)(t + 2) * kstep; const char* b2 = last ? nB : cB + (size_t)(t + 2) * kstep;
            const char* a3 = a2 + kstep; const char* b3 = b2 + kstep;
            PG8_LDB(B0, 0, 0); PG8_LDB(B1, 0, 1); PG8_SCHED; PG8_LDA(At, 0, 0); PG8_STAGE(PG8_SA(1, 1), a1 + hstepA, voffA);
            PG8_WAIT_V(8); PG8_WAIT_L(0); PG8_BAR; PG8_MMA(0, 0, At, B0); PG8_MMA(0, 1, At, B1); PG8_BAR; PG8_SCHED;
            PG8_LDA(At, 0, 1); PG8_STAGE(PG8_SB(0, 0), b2, voffB); PG8_STAGE(PG8_SB(0, 1), b2 + hstepB, voffB); PG8_STAGE(PG8_SA(0, 0), a2, voffA);
            PG8_WAIT_V(8); PG8_WAIT_L(0); PG8_BAR; PG8_MMA(1, 0, At, B0); PG8_MMA(1, 1, At, B1); PG8_BAR; PG8_SCHED;
            PG8_LDB(B0, 1, 0); PG8_LDB(B1, 1, 1); PG8_SCHED; PG8_LDA(At, 1, 0); PG8_STAGE(PG8_SA(0, 1), a2 + hstepA, voffA);
            PG8_WAIT_V(8); PG8_WAIT_L(0); PG8_BAR; PG8_MMA(0, 0, At, B0); PG8_MMA(0, 1, At, B1); PG8_BAR; PG8_SCHED;
            PG8_LDA(At, 1, 1); PG8_STAGE(PG8_SB(1, 0), b3, voffB); PG8_STAGE(PG8_SB(1, 1), b3 + hstepB, voffB); PG8_STAGE(PG8_SA(1, 0), a3, voffA);
            PG8_WAIT_V(8); PG8_WAIT_L(0); PG8_BAR; PG8_MMA(1, 0, At, B0); PG8_MMA(1, 1, At, B1); PG8_BAR; PG8_SCHED;
        }
        if (wr == 0) PG8_BAR;
        E(acc, cur, wr, wc, fr, fq);
        if (!has_next) break;
#pragma unroll
        for (int a = 0; a < 2; ++a)
#pragma unroll
            for (int b = 0; b < 2; ++b)
#pragma unroll
                for (int m = 0; m < 4; ++m)
#pragma unroll
                    for (int n = 0; n < 2; ++n) acc[a][b][m][n] = (f32x4){0.f, 0.f, 0.f, 0.f};
        cur = nxt; cA = nA; cB = nB; ++ui;
        if (wr == 1) PG8_BAR;
    }
    PG8_WAIT_V(0);
    PG8_BAR;
#undef PG8_SA
#undef PG8_SB
#undef PG8_STAGE
#undef PG8_LDA
#undef PG8_LDB
#undef PG8_MMA
#undef PG8_WAIT_V
#undef PG8_WAIT_L
#undef PG8_BAR
#undef PG8_SCHED
}

__device__ __forceinline__ f32x2n swiglu2(f32x2n g, f32x2n u) {
    const f32x2n t = g * -1.4426950408889634f;
    f32x2n e; e.x = __builtin_amdgcn_exp2f(t.x); e.y = __builtin_amdgcn_exp2f(t.y);
    const f32x2n d = e + 1.0f;
    f32x2n r; r.x = __builtin_amdgcn_rcpf(d.x); r.y = __builtin_amdgcn_rcpf(d.y);
    return (g * u) * r;
}
struct EpiSwiglu {
    static constexpr bool PERM = true;
    bf16_t* H;
    __device__ __forceinline__ void operator()(const f32x4 (&acc)[2][2][4][2], const Unit& u, int wr, int wc, int fr, int fq) const {
        const int row0 = u.pm * BM + wr * 64 + fr, col0 = u.pn * 128 + wc * 32 + 8 * fq;
#pragma unroll
        for (int ai = 0; ai < 2; ++ai)
#pragma unroll
            for (int m = 0; m < 4; ++m) {
                const f32x4 g0 = acc[ai][0][m][0], g1 = acc[ai][0][m][1], u0 = acc[ai][1][m][0], u1 = acc[ai][1][m][1];
                const f32x2n a = swiglu2((f32x2n){g0[0], g0[1]}, (f32x2n){u0[0], u0[1]}), b = swiglu2((f32x2n){g0[2], g0[3]}, (f32x2n){u0[2], u0[3]});
                const f32x2n c = swiglu2((f32x2n){g1[0], g1[1]}, (f32x2n){u1[0], u1[1]}), d = swiglu2((f32x2n){g1[2], g1[3]}, (f32x2n){u1[2], u1[3]});
                u32x4 w; w.x = cvt_pk_bf16(a.x, a.y); w.y = cvt_pk_bf16(b.x, b.y); w.z = cvt_pk_bf16(c.x, c.y); w.w = cvt_pk_bf16(d.x, d.y);
                *(u32x4*)(H + (size_t)(row0 + ai * HALF + m * 16) * DFF + col0) = w;
            }
    }
};
struct EpiRes {
    static constexpr bool PERM = false;
    const float* res; float* out; const float* gate; float coef;
    __device__ __forceinline__ void operator()(const f32x4 (&acc)[2][2][4][2], const Unit& u, int wr, int wc, int fr, int fq) const {
        const int row0 = u.pm * BM + wr * 64 + fr, col0 = u.pn * BM + wc * 32 + 4 * fq; const int b = (u.pm * BM) >> 12;
        f32x4 gv[2][2];
#pragma unroll
        for (int bj = 0; bj < 2; ++bj)
#pragma unroll
            for (int n = 0; n < 2; ++n) gv[bj][n] = (*(const f32x4*)(gate + (size_t)b * MODW + col0 + bj * HALF + n * 16) + 1.0f) * coef;
#pragma unroll
        for (int ai = 0; ai < 2; ++ai)
#pragma unroll
            for (int m = 0; m < 4; ++m) { const size_t off = (size_t)(row0 + ai * HALF + m * 16) * DM + col0;
#pragma unroll
                for (int bj = 0; bj < 2; ++bj)
#pragma unroll
                    for (int n = 0; n < 2; ++n) { const f32x4 r = *(const f32x4*)(res + off + bj * HALF + n * 16); *(f32x4*)(out + off + bj * HALF + n * 16) = r * ALPHA + gv[bj][n] * acc[ai][bj][m][n]; }
                asm volatile("" ::: "memory"); }
    }
};
template <int MODE> struct EpiResB {
    static constexpr bool PERM = true;
    const float* resf; const bf16_t* resb; const f32x2n* stats; const float* lng; const float* lnb; bf16_t* out; const float* gate; float coef;
    __device__ __forceinline__ void operator()(const f32x4 (&acc)[2][2][4][2], const Unit& u, int wr, int wc, int fr, int fq) const {
        const int row0 = u.pm * BM + wr * 64 + fr, c8 = u.pn * BM + wc * 32 + 8 * fq; const int b = (u.pm * BM) >> 12;
#pragma unroll
        for (int bj = 0; bj < 2; ++bj) { const int col = c8 + bj * HALF;
            const f32x4 gv0 = (*(const f32x4*)(gate + (size_t)b * MODW + col) + 1.0f) * coef, gv1 = (*(const f32x4*)(gate + (size_t)b * MODW + col + 4) + 1.0f) * coef;
            f32x4 g0, g1, b0, b1;
            if (MODE == 1) { g0 = *(const f32x4*)(lng + col); g1 = *(const f32x4*)(lng + col + 4); b0 = *(const f32x4*)(lnb + col); b1 = *(const f32x4*)(lnb + col + 4); }
#pragma unroll
            for (int ai = 0; ai < 2; ++ai) {
                f32x4 r0[4], r1[4]; u32x4 yv[4]; f32x2n st[4];
#pragma unroll
                for (int m = 0; m < 4; ++m) { const int row = row0 + ai * HALF + m * 16; const size_t off = (size_t)row * DM + col;
                    if (MODE == 0) { r0[m] = *(const f32x4*)(resf + off); r1[m] = *(const f32x4*)(resf + off + 4); }
                    else { yv[m] = *(const u32x4*)(resb + off); st[m] = stats[row]; } }
#pragma unroll
                for (int m = 0; m < 4; ++m) { const int row = row0 + ai * HALF + m * 16; const size_t off = (size_t)row * DM + col;
                    f32x4 x0, x1;
                    if (MODE == 0) { x0 = r0[m]; x1 = r1[m]; }
                    else { const u32x4 y = yv[m];
                        x0 = (f32x4){bflo(y.x), bfhi(y.x), bflo(y.y), bfhi(y.y)}; x1 = (f32x4){bflo(y.z), bfhi(y.z), bflo(y.w), bfhi(y.w)};
                        x0 = (x0 - st[m].x) * st[m].y * g0 + b0; x1 = (x1 - st[m].x) * st[m].y * g1 + b1; }
                    const f32x4 o0 = x0 * ALPHA + gv0 * acc[ai][bj][m][0], o1 = x1 * ALPHA + gv1 * acc[ai][bj][m][1];
                    u32x4 w; w.x = cvt_pk_bf16(o0[0], o0[1]); w.y = cvt_pk_bf16(o0[2], o0[3]); w.z = cvt_pk_bf16(o1[0], o1[1]); w.w = cvt_pk_bf16(o1[2], o1[3]);
                    *(u32x4*)(out + off) = w; }
                asm volatile("" ::: "memory");
            }
        }
    }
};
struct EpiWin {
    static constexpr bool PERM = true;
    bf16_t *QKR, *UE; float* GATES; const float* bias;
    __device__ __forceinline__ void operator()(const f32x4 (&acc)[2][2][4][2], const Unit& u, int wr, int wc, int fr, int fq) const {
        const int c8 = wc * 32 + 8 * fq; const int pn = u.pn;
        if (pn == 8) {
            if (c8 < 16) {
                const f32x4 b0 = *(const f32x4*)(bias + 2048 + c8), b1 = *(const f32x4*)(bias + 2048 + c8 + 4);
#pragma unroll
                for (int ai = 0; ai < 2; ++ai)
#pragma unroll
                    for (int m = 0; m < 4; ++m) { float* gp = GATES + (size_t)(u.pm * BM + wr * 64 + fr + ai * HALF + m * 16) * 16 + c8;
                        *(f32x4*)gp = acc[ai][0][m][0] + b0; *(f32x4*)(gp + 4) = acc[ai][0][m][1] + b1; }
            }
            return;
        }
        bf16_t* base; size_t sa, sm1, sm2, sb;
        if (pn < 6) { bf16_t* buf = QKR + (size_t)(pn >> 1) * (32u << 20); base = buf + (size_t)(u.pm * BM + wr * 64 + fr) * 512 + (pn & 1) * BM + c8; sa = (size_t)HALF * 512; sm1 = 16 * 512; sm2 = 32 * 512; sb = HALF; }
        else { const int ch = (pn - 6) * BM + c8, gq = ch >> 4, hi0 = ch & 15; base = UE + ((size_t)gq * SNROW + u.pm * 8 + wr * 2) * UEXT + fr * 16 + hi0; sa = (size_t)4 * UEXT; sm1 = 256; sm2 = UEXT; sb = (size_t)8 * SNROW * UEXT; }
        const bool sig = (pn == 4 || pn == 5);
#pragma unroll
        for (int bj = 0; bj < 2; ++bj) {
            const f32x4 b0 = *(const f32x4*)(bias + pn * BM + bj * HALF + c8), b1 = *(const f32x4*)(bias + pn * BM + bj * HALF + c8 + 4);
#pragma unroll
            for (int ai = 0; ai < 2; ++ai)
#pragma unroll
                for (int m = 0; m < 4; ++m) { f32x4 v0 = acc[ai][bj][m][0] + b0, v1 = acc[ai][bj][m][1] + b1;
                    if (sig) {
#pragma unroll
                        for (int j = 0; j < 4; ++j) { v0[j] = sigmoidf_(v0[j]); v1[j] = sigmoidf_(v1[j]); } }
                    u32x4 w; w.x = cvt_pk_bf16(v0[0], v0[1]); w.y = cvt_pk_bf16(v0[2], v0[3]); w.z = cvt_pk_bf16(v1[0], v1[1]); w.w = cvt_pk_bf16(v1[2], v1[3]);
                    *(u32x4*)(base + ai * sa + (m & 1) * sm1 + (m >> 1) * sm2 + bj * sb) = w; }
        }
    }
};
struct EpiF32 {
    static constexpr bool PERM = false;
    float* C; int ldc;
    __device__ __forceinline__ void operator()(const f32x4 (&acc)[2][2][4][2], const Unit& u, int wr, int wc, int fr, int fq) const {
        const int row0 = u.pm * BM + wr * 64 + fr, col0 = u.pn * BM + wc * 32 + 4 * fq;
#pragma unroll
        for (int ai = 0; ai < 2; ++ai)
#pragma unroll
            for (int m = 0; m < 4; ++m) { float* rowp = C + (size_t)(row0 + ai * HALF + m * 16) * ldc + col0;
#pragma unroll
                for (int bj = 0; bj < 2; ++bj)
#pragma unroll
                    for (int n = 0; n < 2; ++n) *(f32x4*)(rowp + bj * HALF + n * 16) = acc[ai][bj][m][n]; }
    }
};
struct EpiS5Out {
    static constexpr bool PERM = true;
    bf16_t* Y;
    __device__ __forceinline__ void operator()(const f32x4 (&acc)[2][2][4][2], const Unit& u, int wr, int wc, int fr, int fq) const {
        const int row0 = u.pm * BM + wr * 64 + fr, c8 = u.pn * BM + wc * 32 + 8 * fq;
#pragma unroll
        for (int ai = 0; ai < 2; ++ai)
#pragma unroll
            for (int m = 0; m < 4; ++m) { const int row = row0 + ai * HALF + m * 16, gq = row / SNROW, r = row % SNROW;
#pragma unroll
                for (int bj = 0; bj < 2; ++bj) { const f32x4 v0 = acc[ai][bj][m][0], v1 = acc[ai][bj][m][1]; const int col = c8 + bj * HALF, t = col >> 4, ho0 = col & 15;
                    u32x4 w; w.x = cvt_pk_bf16(gelu_tanh(v0[0]), gelu_tanh(v0[1])); w.y = cvt_pk_bf16(gelu_tanh(v0[2]), gelu_tanh(v0[3]));
                    w.z = cvt_pk_bf16(gelu_tanh(v1[0]), gelu_tanh(v1[1])); w.w = cvt_pk_bf16(gelu_tanh(v1[2]), gelu_tanh(v1[3]));
                    *(u32x4*)(Y + ((size_t)r * SL + t) * 512 + gq * 16 + ho0) = w; } }
    }
};
struct EpiGlu {
    static constexpr bool PERM = true;
    const bf16_t* Y; bf16_t* Z; const float* bias;
    __device__ __forceinline__ void operator()(const f32x4 (&acc)[2][2][4][2], const Unit& u, int wr, int wc, int fr, int fq) const {
        const int row0 = u.pm * BM + wr * 64 + fr, c8 = u.pn * BM + wc * 32 + 8 * fq;
#pragma unroll
        for (int bj = 0; bj < 2; ++bj) {
            const f32x4 b0 = *(const f32x4*)(bias + c8 + bj * HALF), b1 = *(const f32x4*)(bias + c8 + bj * HALF + 4);
            u32x4 yv[8];
#pragma unroll
            for (int q = 0; q < 8; ++q) yv[q] = *(const u32x4*)(Y + (size_t)(row0 + (q >> 2) * HALF + (q & 3) * 16) * 512 + c8 + bj * HALF);
#pragma unroll
            for (int q = 0; q < 8; ++q) { const int ai = q >> 2, m = q & 3; const size_t off = (size_t)(row0 + ai * HALF + m * 16) * 512 + c8 + bj * HALF;
                const f32x4 v0 = acc[ai][bj][m][0] + b0, v1 = acc[ai][bj][m][1] + b1; const u32x4 y = yv[q];
                u32x4 w; w.x = cvt_pk_bf16(bflo(y.x) * sigmoidf_(v0[0]), bfhi(y.x) * sigmoidf_(v0[1])); w.y = cvt_pk_bf16(bflo(y.y) * sigmoidf_(v0[2]), bfhi(y.y) * sigmoidf_(v0[3]));
                w.z = cvt_pk_bf16(bflo(y.z) * sigmoidf_(v1[0]), bfhi(y.z) * sigmoidf_(v1[1])); w.w = cvt_pk_bf16(bflo(y.w) * sigmoidf_(v1[2]), bfhi(y.w) * sigmoidf_(v1[3]));
                *(u32x4*)(Z + off) = w; }
        }
    }
};
}

struct Args { const float* in[31]; float* out; unsigned char* ws; int ph_lo, ph_hi; };

template <int MODE> __device__ __forceinline__ int dest_row(int n) {
    if (MODE == 1) { if (n < DFF) return (n >> 7) * 256 + (n & 127); n -= DFF; return (n >> 7) * 256 + 128 + (n & 127); }
    if (MODE == 2) { if (n < 1536) return n; if (n < 1552) return 2048 + (n - 1536); return n - 16; }
    return n;
}
template <int MODE> __device__ __forceinline__ void transpose_item(const float* W, int K, int N, bf16_t* WT, LAS float* scr, int item, int lane) {
    const int nblk = (N + 31) / 32, kb = item / nblk, nb = item % nblk, k0 = 64 * kb, n0 = 32 * nb;
    const int nn = n0 + (lane & 31);
    float wl[32];
#pragma unroll
    for (int i = 0; i < 32; ++i) { const int kk = 2 * i + (lane >> 5); wl[i] = (nn < N) ? W[(size_t)(k0 + kk) * N + nn] : 0.f; }
#pragma unroll
    for (int i = 0; i < 32; ++i) { const int kk = 2 * i + (lane >> 5); scr[kk * 33 + (lane & 31)] = wl[i]; }
    asm volatile("s_waitcnt lgkmcnt(0)" ::: "memory");
    const int c = lane & 7;
#pragma unroll
    for (int j = 0; j < 4; ++j) { const int nl = (lane >> 3) + 8 * j; const LAS float* s = scr + (8 * c) * 33 + nl;
        u32x4 o; o.x = cvt_pk_bf16(s[0 * 33], s[1 * 33]); o.y = cvt_pk_bf16(s[2 * 33], s[3 * 33]); o.z = cvt_pk_bf16(s[4 * 33], s[5 * 33]); o.w = cvt_pk_bf16(s[6 * 33], s[7 * 33]);
        if (n0 + nl < N) *(u32x4*)(WT + (size_t)dest_row<MODE>(n0 + nl) * K + k0 + 8 * c) = o; }
    asm volatile("s_waitcnt lgkmcnt(0)" ::: "memory");
}

__device__ __forceinline__ void phase0(const Args& a, LAS unsigned char* lds) {
    const int tid = threadIdx.x, lane = tid & 63, wave = tid >> 6, G = gridDim.x, blk = blockIdx.x;
    unsigned char* ws = a.ws;
    {
        LAS float* sc = (LAS float*)lds;
        const float* c = a.in[1];
        for (int i = tid; i < NB * DM; i += 512) sc[i] = siluf_(c[i]);
        __syncthreads();
        float* modp = (float*)(ws + WS_MODP);
        for (int idx = blk * 512 + tid; idx < MODW * 16; idx += G * 512) {
            const int j = idx % MODW, ks = idx / MODW;
            float acc[16];
#pragma unroll
            for (int b = 0; b < 16; ++b) acc[b] = 0.f;
            const float* w = a.in[2] + (size_t)(ks * 64) * MODW + j;
            const LAS float* scp = sc + ks * 64;
#pragma unroll 1
            for (int k0 = 0; k0 < 64; k0 += 16) { float wv[16];
#pragma unroll
                for (int k = 0; k < 16; ++k) wv[k] = w[(size_t)(k0 + k) * MODW];
#pragma unroll
                for (int k = 0; k < 16; ++k)
#pragma unroll
                    for (int b = 0; b < 16; ++b) acc[b] += scp[b * DM + k0 + k] * wv[k]; }
#pragma unroll
            for (int b = 0; b < 16; ++b) modp[(size_t)(ks * 16 + b) * MODW + j] = acc[b];
        }
        __syncthreads();
    }
    {
        LAS float* Er = (LAS float*)lds; LAS float* Ei = Er + 1024; LAS float* A1r = Ei + 1024; LAS float* A1i = A1r + 1024;
        LAS float* Cr = A1i + 1024; LAS float* Ci = Cr + 1024; LAS float* Br = Ci + 1024; LAS float* Bi = Br + 1024;
        const float *lam_re = a.in[13], *lam_im = a.in[14], *log_step = a.in[15], *b_re = a.in[16], *b_im = a.in[17], *c_re = a.in[18], *c_im = a.in[19];
        float* Ktab = (float*)(ws + WS_KTAB); bf16_t* Bt1 = (bf16_t*)(ws + WS_BT1); bf16_t* Bt2 = (bf16_t*)(ws + WS_BT2);
        for (int it = blk; it < 32 * 2 * (SL / 16); it += G) {
            const int g = it / (2 * (SL / 16)), d = (it / (SL / 16)) & 1, tq = it % (SL / 16);
            for (int e = tid; e < 1024; e += 512) {
                const int tl = e >> 6, p = e & 63, tau = tq * 16 + tl;
                const float lr = lam_re[(d * 32 + g) * 64 + p], li = lam_im[(d * 32 + g) * 64 + p], step = expf(log_step[d * 32 + g]);
                float ar, ai; cpow(lr, li, step, 1, ar, ai);
                const float nr = ar - 1.f, ni = ai, inv = 1.f / (lr * lr + li * li);
                const float cfr = (nr * lr + ni * li) * inv, cfi = (ni * lr - nr * li) * inv;
                float pr, pi; cpow(lr, li, step, tau, pr, pi);
                Er[e] = pr * cfr - pi * cfi; Ei[e] = pr * cfi + pi * cfr;
                float qr, qi; cpow(lr, li, step, tau + 1, qr, qi);
                A1r[e] = qr; A1i[e] = qi;
                Cr[e] = c_re[(size_t)((d * 32 + g) * 16) * 64 + e]; Ci[e] = c_im[(size_t)((d * 32 + g) * 16) * 64 + e];
                Br[e] = b_re[(size_t)g * 1024 + e]; Bi[e] = b_im[(size_t)g * 1024 + e];
            }
            __syncthreads();
            { const int hh = tid & 1, ho = (tid >> 1) & 15, tl = tid >> 5;
              f32x4 s0 = {0.f, 0.f, 0.f, 0.f}, s1 = {0.f, 0.f, 0.f, 0.f};
              for (int p = 0; p < 64; ++p) { const float cr = Cr[ho * 64 + p], ci = Ci[ho * 64 + p], er = Er[tl * 64 + p], ei = Ei[tl * 64 + p];
                  const float cer = cr * er - ci * ei, cei = cr * ei + ci * er;
                  const f32x4 br0 = *(const LAS f32x4*)(Br + p * 16 + hh * 8), br1 = *(const LAS f32x4*)(Br + p * 16 + hh * 8 + 4), bi0 = *(const LAS f32x4*)(Bi + p * 16 + hh * 8), bi1 = *(const LAS f32x4*)(Bi + p * 16 + hh * 8 + 4);
                  s0 += br0 * cer - bi0 * cei; s1 += br1 * cer - bi1 * cei; }
              float* kp = Ktab + (size_t)(((g * 2 + d) * SL) + tq * 16 + tl) * 256 + ho * 16 + hh * 8;
              *(f32x4*)kp = s0; *(f32x4*)(kp + 4) = s1; }
            for (int q = tid; q < 2048; q += 512) {
                const int nl = q & 127, tl = q >> 7, ri = nl >> 6, p = nl & 63, tau = tq * 16 + tl, s = d ? tau : SL - 1 - tau;
                const float er = Er[tl * 64 + p], ei = Ei[tl * 64 + p];
                unsigned w[8];
#pragma unroll
                for (int h2 = 0; h2 < 8; ++h2) { const float br0 = Br[p * 16 + 2 * h2], bi0 = Bi[p * 16 + 2 * h2], br1 = Br[p * 16 + 2 * h2 + 1], bi1 = Bi[p * 16 + 2 * h2 + 1];
                    const float v0 = ri ? (er * bi0 + ei * br0) : (er * br0 - ei * bi0), v1 = ri ? (er * bi1 + ei * br1) : (er * br1 - ei * bi1);
                    w[h2] = cvt_pk_bf16(v0, v1); }
                bf16_t* dst = Bt1 + ((size_t)g * 256 + d * 128 + nl) * UK + s * 16;
                *(u32x4*)dst = (u32x4){w[0], w[1], w[2], w[3]}; *(u32x4*)(dst + 8) = (u32x4){w[4], w[5], w[6], w[7]};
            }
            for (int q = tid; q < 4096; q += 512) {
                const int pg = q & 7, ri = (q >> 3) & 1, ho = (q >> 4) & 15, tl = q >> 8, tau = tq * 16 + tl, t = d ? SL - 1 - tau : tau;
                unsigned w[4];
#pragma unroll
                for (int j2 = 0; j2 < 4; ++j2) { float v[2];
#pragma unroll
                    for (int e2 = 0; e2 < 2; ++e2) { const int p = pg * 8 + j2 * 2 + e2; const float cr = Cr[ho * 64 + p], ci = Ci[ho * 64 + p], qr = A1r[tl * 64 + p], qi = A1i[tl * 64 + p];
                        v[e2] = ri ? -(cr * qi + ci * qr) : (cr * qr - ci * qi); }
                    w[j2] = cvt_pk_bf16(v[0], v[1]); }
                *(u32x4*)(Bt2 + ((size_t)g * UK + t * 16 + ho) * UEXT + UK + d * 128 + ri * 64 + pg * 8) = (u32x4){w[0], w[1], w[2], w[3]};
            }
            __syncthreads();
        }
    }
    {
        LAS float* scr = (LAS float*)(lds + wave * 16384);
        const int gw = blk * 8 + wave, NGW = G * 8;
        constexpr int I_UP = 16 * 176, I_DN = 44 * 32, I_IN = 16 * 65, I_OUT = 16 * 32, I_GLU = 8 * 16;
        constexpr int NITEMS = 2 * I_UP + 2 * I_DN + I_IN + I_OUT + I_GLU;
        for (int it = gw; it < NITEMS; it += NGW) {
            int r = it;
            if (r < I_UP) { transpose_item<1>(a.in[4], DM, NUP, (bf16_t*)(ws + WS_WUP1), scr, r, lane); continue; } r -= I_UP;
            if (r < I_UP) { transpose_item<1>(a.in[27], DM, NUP, (bf16_t*)(ws + WS_WUP2), scr, r, lane); continue; } r -= I_UP;
            if (r < I_DN) { transpose_item<0>(a.in[5], DFF, DM, (bf16_t*)(ws + WS_WDN1), scr, r, lane); continue; } r -= I_DN;
            if (r < I_DN) { transpose_item<0>(a.in[28], DFF, DM, (bf16_t*)(ws + WS_WDN2), scr, r, lane); continue; } r -= I_DN;
            if (r < I_IN) { transpose_item<2>(a.in[8], DM, NIN, (bf16_t*)(ws + WS_WIN), scr, r, lane); continue; } r -= I_IN;
            if (r < I_OUT) { transpose_item<0>(a.in[24], DM, DM, (bf16_t*)(ws + WS_WOUT), scr, r, lane); continue; } r -= I_OUT;
            transpose_item<0>(a.in[21], 512, 512, (bf16_t*)(ws + WS_WGLU), scr, r, lane);
        }
        const int gt = blk * 512 + tid, GT = G * 512;
        u32x4* padp = (u32x4*)((bf16_t*)(ws + WS_WIN) + (size_t)NIN * DM);
        for (int i = gt; i < (NINP - NIN) * DM / 8; i += GT) padp[i] = (u32x4){0u, 0u, 0u, 0u};
        float* binp = (float*)(ws + WS_BIN);
        for (int i = gt; i < NINP; i += GT) { if (i < NIN) binp[dest_row<2>(i)] = a.in[9][i]; else binp[i] = 0.f; }
    }
}

__device__ __forceinline__ void phase1(const Args& a, LAS unsigned char* lds) {
    const int tid = threadIdx.x, lane = tid & 63, wave = tid >> 6, G = gridDim.x;
    const int gt = blockIdx.x * 512 + tid, GT = G * 512;
    unsigned char* ws = a.ws;
    const float* modp = (const float*)(ws + WS_MODP); float* mod = (float*)(ws + WS_MOD); const float* b_ada = a.in[3];
    LAS float* lsh = (LAS float*)lds;
    bf16_t* xm = (bf16_t*)(ws + WS_XM); const float* x = a.in[0];
    for (int rb = blockIdx.x; rb < MTOK / 256; rb += G) {
        const int b = rb >> 4;
        __syncthreads();
        for (int i = tid; i < 2048; i += 512) { float s = b_ada[i];
#pragma unroll
            for (int ks = 0; ks < 16; ++ks) s += modp[(size_t)(ks * 16 + b) * MODW + i];
            lsh[i] = (i >= 1024) ? s + 1.0f : s; }
        __syncthreads();
        f32x4 s0[4], s1[4];
#pragma unroll
        for (int j = 0; j < 4; ++j) { s0[j] = *((const LAS f32x4*)lsh + lane + 64 * j); s1[j] = *((const LAS f32x4*)(lsh + 1024) + lane + 64 * j); }
        for (int it = 0; it < 8; ++it) { const int row0 = rb * 256 + it * 32 + wave * 4;
            f32x4 v[4][4];
#pragma unroll
            for (int r = 0; r < 4; ++r)
#pragma unroll
                for (int j = 0; j < 4; ++j) v[r][j] = *((const f32x4*)(x + (size_t)(row0 + r) * DM) + lane + 64 * j);
#pragma unroll
            for (int r = 0; r < 4; ++r)
#pragma unroll
                for (int j = 0; j < 4; ++j) { const f32x4 o = v[r][j] * s1[j] + s0[j]; u32x2 w; w.x = cvt_pk_bf16(o[0], o[1]); w.y = cvt_pk_bf16(o[2], o[3]); *((u32x2*)(xm + (size_t)(row0 + r) * DM) + lane + 64 * j) = w; } }
    }
    for (int i = gt; i < NB * MODW; i += GT) { const int b = i / MODW, j = i % MODW; float s = b_ada[j];
#pragma unroll
        for (int ks = 0; ks < 16; ++ks) s += modp[(size_t)(ks * 16 + b) * MODW + j];
        mod[i] = s; }
}
__device__ __forceinline__ void tbuild(const Args& a, int vb, int nvb) {
    const int gt = vb * 512 + threadIdx.x, GT = nvb * 512;
    unsigned char* ws = a.ws;
    const float* Ktab = (const float*)(ws + WS_KTAB); bf16_t* Bt2 = (bf16_t*)(ws + WS_BT2); const float* dsk = a.in[20];
    constexpr int TB_N = 32 * UK * (UK / 8);
    for (int i0 = gt; i0 < TB_N; i0 += 4 * GT) {
        f32x4 v0[4], v1[4];
#pragma unroll
        for (int u = 0; u < 4; ++u) { const int i = i0 + u * GT; if (i < TB_N) {
            const int kg = i % (UK / 8), n = (i / (UK / 8)) % UK, g = i / ((UK / 8) * UK), t = n >> 4, ho = n & 15, s = kg >> 1, hi0 = (kg & 1) * 8;
            const int dsel = (s > t) ? 1 : 0, lag = (s < t) ? (t - s) : (s - t);
            const float* p = Ktab + (size_t)((g * 2 + dsel) * SL + lag) * 256 + ho * 16 + hi0; v0[u] = *(const f32x4*)p; v1[u] = *(const f32x4*)(p + 4);
            if (s == t) { const float* q = Ktab + (size_t)((g * 2 + 1) * SL) * 256 + ho * 16 + hi0; v0[u] += *(const f32x4*)q; v1[u] += *(const f32x4*)(q + 4);
                const float dd = dsk[g * 16 + ho];
#pragma unroll
                for (int j = 0; j < 4; ++j) { v0[u][j] += (hi0 + j == ho) ? dd : 0.f; v1[u][j] += (hi0 + 4 + j == ho) ? dd : 0.f; } } } }
#pragma unroll
        for (int u = 0; u < 4; ++u) { const int i = i0 + u * GT; if (i < TB_N) {
            const int kg = i % (UK / 8), n = (i / (UK / 8)) % UK, g = i / ((UK / 8) * UK);
            u32x4 w; w.x = cvt_pk_bf16(v0[u][0], v0[u][1]); w.y = cvt_pk_bf16(v0[u][2], v0[u][3]); w.z = cvt_pk_bf16(v1[u][0], v1[u][1]); w.w = cvt_pk_bf16(v1[u][2], v1[u][3]);
            *(u32x4*)(Bt2 + ((size_t)g * UK + n) * UEXT + kg * 8) = w; } }
    }
}

__device__ __forceinline__ void mod_pass(const float* src, const float* mod, int sub, bf16_t* xm) {
    const int lane = threadIdx.x & 63, gw = blockIdx.x * 8 + (threadIdx.x >> 6), NGW = gridDim.x * 8;
    for (int row0 = gw * 4; row0 < MTOK; row0 += NGW * 4) {
        const int b = row0 >> 12;
        f32x4 v[4][4];
#pragma unroll
        for (int r = 0; r < 4; ++r)
#pragma unroll
            for (int j = 0; j < 4; ++j) v[r][j] = *((const f32x4*)(src + (size_t)(row0 + r) * DM) + lane + 64 * j);
        const f32x4* sh = (const f32x4*)(mod + (size_t)b * MODW + sub * 3072) + lane; const f32x4* scl = (const f32x4*)(mod + (size_t)b * MODW + sub * 3072 + 1024) + lane;
#pragma unroll
        for (int j = 0; j < 4; ++j) { const f32x4 s1 = scl[64 * j] + 1.0f, s0 = sh[64 * j];
#pragma unroll
            for (int r = 0; r < 4; ++r) { const f32x4 o = v[r][j] * s1 + s0; u32x2 w; w.x = cvt_pk_bf16(o[0], o[1]); w.y = cvt_pk_bf16(o[2], o[3]); *((u32x2*)(xm + (size_t)(row0 + r) * DM) + lane + 64 * j) = w; } }
    }
}

template <bool FINAL>
__device__ __forceinline__ void row_pass_b(const bf16_t* src, f32x2n* stats, const float* lng, const float* lnb, const float* mod, int sub, bf16_t* xm, float* outf) {
    const int lane = threadIdx.x & 63, gw = blockIdx.x * 8 + (threadIdx.x >> 6), NGW = gridDim.x * 8;
    f32x4 gg[4], bb[4];
#pragma unroll
    for (int j = 0; j < 2; ++j) { gg[2 * j] = *(const f32x4*)(lng + lane * 8 + 512 * j); gg[2 * j + 1] = *(const f32x4*)(lng + lane * 8 + 512 * j + 4);
        bb[2 * j] = *(const f32x4*)(lnb + lane * 8 + 512 * j); bb[2 * j + 1] = *(const f32x4*)(lnb + lane * 8 + 512 * j + 4); }
    for (int row0 = gw * 4; row0 < MTOK; row0 += NGW * 4) {
        const int b = row0 >> 12;
        u32x4 raw[4][2];
#pragma unroll
        for (int r = 0; r < 4; ++r)
#pragma unroll
            for (int j = 0; j < 2; ++j) raw[r][j] = *(const u32x4*)(src + (size_t)(row0 + r) * DM + lane * 8 + 512 * j);
#pragma unroll
        for (int r = 0; r < 4; ++r) { const int row = row0 + r;
            f32x4 v[4];
#pragma unroll
            for (int j = 0; j < 2; ++j) { const u32x4 y = raw[r][j];
                v[2 * j] = (f32x4){bflo(y.x), bfhi(y.x), bflo(y.y), bfhi(y.y)}; v[2 * j + 1] = (f32x4){bflo(y.z), bfhi(y.z), bflo(y.w), bfhi(y.w)}; }
            float s = 0.f;
#pragma unroll
            for (int j = 0; j < 4; ++j) s += (v[j][0] + v[j][1]) + (v[j][2] + v[j][3]);
            const float mean = wave_sum(s) * (1.f / DM); float s2 = 0.f;
#pragma unroll
            for (int j = 0; j < 4; ++j) { const f32x4 d = v[j] - mean; s2 += (d[0] * d[0] + d[1] * d[1]) + (d[2] * d[2] + d[3] * d[3]); }
            const float rstd = 1.f / sqrtf(wave_sum(s2) * (1.f / DM) + LN_EPS);
#pragma unroll
            for (int j = 0; j < 4; ++j) v[j] = (v[j] - mean) * rstd * gg[j] + bb[j];
            if (FINAL) {
#pragma unroll
                for (int j = 0; j < 2; ++j) { float* o = outf + (size_t)row * DM + lane * 8 + 512 * j; *(f32x4*)o = v[2 * j]; *(f32x4*)(o + 4) = v[2 * j + 1]; }
            } else {
                if (lane == 0) stats[row] = (f32x2n){mean, rstd};
                const float* sh = mod + (size_t)b * MODW + sub * 3072 + lane * 8; const float* scl = sh + 1024;
#pragma unroll
                for (int j = 0; j < 2; ++j) { const f32x4 o0 = v[2 * j] * (*(const f32x4*)(scl + 512 * j) + 1.0f) + *(const f32x4*)(sh + 512 * j), o1 = v[2 * j + 1] * (*(const f32x4*)(scl + 512 * j + 4) + 1.0f) + *(const f32x4*)(sh + 512 * j + 4);
                    u32x4 w; w.x = cvt_pk_bf16(o0[0], o0[1]); w.y = cvt_pk_bf16(o0[2], o0[3]); w.z = cvt_pk_bf16(o1[0], o1[1]); w.w = cvt_pk_bf16(o1[2], o1[3]);
                    *(u32x4*)(xm + (size_t)row * DM + lane * 8 + 512 * j) = w; }
            }
        }
    }
}

__device__ __forceinline__ void phase_conv(const Args& a) {
    const int gt = blockIdx.x * 512 + threadIdx.x, GT = gridDim.x * 512;
    const bf16_t* qkr = (const bf16_t*)(a.ws + WS_QKR); bf16_t* qkc = (bf16_t*)(a.ws + WS_QKC); const float* cw = a.in[10]; const float* cb = a.in[11];
    for (int i = gt; i < (MTOK / 4) * 64; i += GT) {
        const int cg8 = i & 63, tok0 = (i >> 6) * 4, pos0 = tok0 & (SEQ - 1), c0 = cg8 * 8;
        u32x4 x[8];
#pragma unroll
        for (int r = 0; r < 8; ++r) { const int pp = pos0 + r - 2; x[r] = (pp >= 0 && pp < SEQ) ? *(const u32x4*)(qkr + (size_t)(tok0 + r - 2) * 512 + c0) : (u32x4){0u, 0u, 0u, 0u}; }
        f32x4 w0[5], w1[5];
#pragma unroll
        for (int jj = 0; jj < 5; ++jj) { w0[jj] = *(const f32x4*)(cw + jj * 512 + c0); w1[jj] = *(const f32x4*)(cw + jj * 512 + c0 + 4); }
        const f32x4 b0 = *(const f32x4*)(cb + c0), b1 = *(const f32x4*)(cb + c0 + 4);
        const float sc = (c0 >= 256) ? 0.125f : 1.0f;
#pragma unroll
        for (int t = 0; t < 4; ++t) {
            f32x4 a0 = b0, a1 = b1;
#pragma unroll
            for (int jj = 0; jj < 5; ++jj) { const u32x4 xv = x[t + jj];
                a0 += (f32x4){bflo(xv.x), bfhi(xv.x), bflo(xv.y), bfhi(xv.y)} * w0[jj]; a1 += (f32x4){bflo(xv.z), bfhi(xv.z), bflo(xv.w), bfhi(xv.w)} * w1[jj]; }
            u32x4 w; w.x = cvt_pk_bf16(siluf_(a0[0]) * sc, siluf_(a0[1]) * sc); w.y = cvt_pk_bf16(siluf_(a0[2]) * sc, siluf_(a0[3]) * sc);
            w.z = cvt_pk_bf16(siluf_(a1[0]) * sc, siluf_(a1[1]) * sc); w.w = cvt_pk_bf16(siluf_(a1[2]) * sc, siluf_(a1[3]) * sc);
            *(u32x4*)(qkc + (size_t)(tok0 + t) * 512 + c0) = w;
        }
    }
}

namespace ml {
constexpr int QS = 0, KS = 18432, VT = 36864, PS = 80384, CT = 115200, SM = 138240;
constexpr int QSTR = 72, KSTR = 72, VSTR = 136, PSTR = 136, CSTR = 72, KWSTR = 136;
template <int KS>
__device__ __forceinline__ f32x16 mma_tile_t(f32x16 acc, const LAS bf16_t* A, int lda, const LAS bf16_t* B, int ldb, int lane) {
    const LAS bf16_t* ap = A + (lane & 31) * lda + (lane >> 5) * 8; const LAS bf16_t* bp = B + (lane & 31) * ldb + (lane >> 5) * 8;
#pragma unroll
    for (int k0 = 0; k0 < KS; k0 += 4) {
        bf16x8 av[4], bv[4];
#pragma unroll
        for (int k = 0; k < 4; ++k) if (k0 + k < KS) { av[k] = *(const LAS bf16x8*)(ap + (k0 + k) * 16); bv[k] = *(const LAS bf16x8*)(bp + (k0 + k) * 16); }
#pragma unroll
        for (int k = 0; k < 4; ++k) if (k0 + k < KS) acc = __builtin_amdgcn_mfma_f32_32x32x16_bf16(av[k], bv[k], acc, 0, 0, 0);
    }
    return acc;
}
__device__ __forceinline__ f32x16 mma_tile(f32x16 acc, const LAS bf16_t* A, int lda, const LAS bf16_t* B, int ldb, int ksteps, int lane) {
    switch (ksteps) {
    case 2: return mma_tile_t<2>(acc, A, lda, B, ldb, lane);
    case 4: return mma_tile_t<4>(acc, A, lda, B, ldb, lane);
    case 6: return mma_tile_t<6>(acc, A, lda, B, ldb, lane);
    default: return mma_tile_t<8>(acc, A, lda, B, ldb, lane);
    }
}
__device__ __forceinline__ float gate_scan(const LAS float* gis, const LAS float* lfs, LAS float* aS, float m_mem, int lane) {
    LAS float* Mt = aS + 128; LAS float* wint = Mt + 128; LAS float* emt = wint + 128; LAS float* wst = emt + 128; LAS float* eM = wst + 128; LAS float* scal = eM + 128;
    const float l0 = lfs[2 * lane], l1 = lfs[2 * lane + 1]; const float ps = l0 + l1; float incl = ps;
#pragma unroll
    for (int o = 1; o < 64; o <<= 1) { const float t = __shfl_up(incl, o); if (lane >= o) incl += t; }
    const float excl = incl - ps, b0 = excl + l0, b1 = excl + ps;
    const float a0 = gis[2 * lane] - b0, a1 = gis[2 * lane + 1] - b1;
    float inclm = fmaxf(a0, a1);
#pragma unroll
    for (int o = 1; o < 64; o <<= 1) { const float t = __shfl_up(inclm, o); if (lane >= o) inclm = fmaxf(inclm, t); }
    float exclm = __shfl_up(inclm, 1); if (lane == 0) exclm = -3.0e38f;
    const float pm0 = fmaxf(exclm, a0), pm1 = fmaxf(pm0, a1);
    const float M0 = fmaxf(m_mem, pm0), M1 = fmaxf(m_mem, pm1);
    aS[2 * lane] = a0; aS[2 * lane + 1] = a1; Mt[2 * lane] = M0; Mt[2 * lane + 1] = M1;
    wint[2 * lane] = __expf(m_mem - M0); wint[2 * lane + 1] = __expf(m_mem - M1);
    emt[2 * lane] = __expf(-(b0 + M0)); emt[2 * lane + 1] = __expf(-(b1 + M1));
    const float Mlast = __shfl(M1, 63), bend = __shfl(b1, 63);
    wst[2 * lane] = __expf(a0 - Mlast); wst[2 * lane + 1] = __expf(a1 - Mlast);
    eM[2 * lane] = __expf(fminf(Mlast - M0, 80.f)); eM[2 * lane + 1] = __expf(fminf(Mlast - M1, 80.f));
    if (lane == 0) scal[0] = __expf(m_mem - Mlast);
    return bend + Mlast;
}
constexpr int SCB = 3136;
__device__ __forceinline__ void run(const bf16_t* qkc, const bf16_t* vbuf, const float* gates, bf16_t* hout, int b, int h, int dir, LAS unsigned char* lds) {
    const int tid = threadIdx.x, lane = tid & 63, w = __builtin_amdgcn_readfirstlane(tid >> 6);
#define ML_PTRS(L, cb) LAS bf16_t* Qs = (LAS bf16_t*)((L) + QS); LAS bf16_t* Ks = (LAS bf16_t*)((L) + KS); LAS bf16_t* Vt = (LAS bf16_t*)((L) + VT); \
    LAS bf16_t* Ps = (LAS bf16_t*)((L) + PS); LAS bf16_t* Ct = (LAS bf16_t*)((L) + CT); \
    LAS float* aS = (LAS float*)((L) + SM + (cb) * SCB); LAS float* Mt = aS + 128; LAS float* wint = Mt + 128; LAS float* emt = wint + 128; LAS float* wst = emt + 128; LAS float* eMt = wst + 128; LAS float* scal = eMt + 128; (void)eMt; \
    LAS float* aSn = (LAS float*)((L) + SM + (1 - (cb)) * SCB); \
    LAS float* den = (LAS float*)((L) + SM + 2 * SCB); LAS float* gis = den + 128; LAS float* lfs = gis + 128; LAS float* den1 = lfs + 128; LAS float* qn = den1 + 128; (void)den1; (void)qn; \
    (void)Qs; (void)Ks; (void)Vt; (void)Ps; (void)Ct; (void)aS; (void)Mt; (void)wint; (void)emt; (void)den; (void)wst; (void)gis; (void)lfs; (void)scal; (void)aSn
    for (int i = tid; i < 160 * CSTR / 2; i += 512) ((LAS unsigned*)(lds + CT))[i] = 0u;
    for (int i = tid; i < 32 * VSTR / 2; i += 512) ((LAS unsigned*)(lds + VT + 128 * VSTR * 2))[i] = (i < VSTR / 2) ? 0x3F803F80u : 0u;
    f32x16 accC0;
#pragma unroll
    for (int i = 0; i < 16; ++i) accC0[i] = 0.f;
    float nst = 0.f;
    float m_mem = 0.f;
    const int tokbase = b * SEQ; const int sgn = dir ? -1 : 1;
    u32x4 qreg[2], kreg[2], vreg[4]; float gi_r = 0.f, gf_r = 0.f;
#define ML_BAR() do { asm volatile("s_waitcnt lgkmcnt(0)" ::: "memory"); __builtin_amdgcn_s_barrier(); asm volatile("" ::: "memory"); } while (0)
#define ML_POS(cc, r) (((dir) ? ((31 - (cc)) * 128 + 127) : ((cc) * 128)) + sgn * (r))
#define ML_LOAD(cc) do { \
    _Pragma("unroll") for (int i = 0; i < 2; ++i) { const int pc = tid + 512 * i, r = pc >> 3, c = pc & 7; qreg[i] = *(const u32x4*)(qkc + (size_t)(tokbase + ML_POS(cc, r)) * 512 + h * 64 + c * 8); } \
    _Pragma("unroll") for (int i = 0; i < 2; ++i) { const int r = tid & 127, c = (tid >> 7) + 4 * i; kreg[i] = *(const u32x4*)(qkc + (size_t)(tokbase + ML_POS(cc, r)) * 512 + 256 + h * 64 + c * 8); } \
    _Pragma("unroll") for (int i = 0; i < 4; ++i) { const int r = tid & 127, c = (tid >> 7) + 4 * i; vreg[i] = *(const u32x4*)(vbuf + (size_t)(tokbase + ML_POS(cc, r)) * 512 + h * 128 + c * 8); } } while (0)
#define ML_LOADG(cc) do { if (tid < 128) { const float* gp = gates + (size_t)(tokbase + ML_POS(cc, tid)) * 16 + dir * 4 + h; gi_r = gp[0]; gf_r = gp[8]; } } while (0)
#define ML_PUTG() do { if (tid < 128) { gis[tid] = gi_r; lfs[tid] = fminf(gf_r, 0.f) - __logf(1.0f + __expf(-fabsf(gf_r))); } } while (0)
    { ML_PTRS(lds, 0);
      ML_LOADG(0); ML_LOAD(0);
      ML_PUTG();
      __syncthreads();
      if (w == 1) m_mem = gate_scan(gis, lfs, aS, m_mem, lane);
      ML_LOADG(1);
      __syncthreads(); }
    for (int cc = 0; cc < 32; ++cc) {
        unsigned zo = 0u; asm volatile("" : "+s"(zo));
        LAS unsigned char* L = lds + zo;
        const int cb = cc & 1;
        ML_PTRS(L, cb);
#pragma unroll
        for (int i = 0; i < 2; ++i) { const int pc = tid + 512 * i, r = pc >> 3, c = pc & 7; *(LAS u32x4*)(Qs + r * QSTR + c * 8) = qreg[i]; }
#pragma unroll
        for (int i = 0; i < 2; ++i) { const int r = tid & 127, c = (tid >> 7) + 4 * i; *(LAS u32x4*)(Ks + r * KSTR + c * 8) = kreg[i]; }
#pragma unroll
        for (int i = 0; i < 4; ++i) { const int r = tid & 127, c = (tid >> 7) + 4 * i; const u32x4 x = vreg[i]; LAS bf16_t* vp = Vt + (c * 8) * VSTR + r;
            vp[0 * VSTR] = (bf16_t)(x.x & 0xffffu); vp[1 * VSTR] = (bf16_t)(x.x >> 16); vp[2 * VSTR] = (bf16_t)(x.y & 0xffffu); vp[3 * VSTR] = (bf16_t)(x.y >> 16);
            vp[4 * VSTR] = (bf16_t)(x.z & 0xffffu); vp[5 * VSTR] = (bf16_t)(x.z >> 16); vp[6 * VSTR] = (bf16_t)(x.w & 0xffffu); vp[7 * VSTR] = (bf16_t)(x.w >> 16); }
        ML_PUTG();
        ML_BAR();
        const int rb = w >> 1, par = w & 1;
        if (w == 1) { if (cc + 1 < 32) m_mem = gate_scan(gis, lfs, aSn, m_mem, lane); }
        else if (w == 3) {
#pragma unroll 1
            for (int rq = 0; rq < 4; ++rq) { f32x16 aq;
#pragma unroll
                for (int i = 0; i < 16; ++i) aq[i] = 0.f;
                aq = mma_tile(aq, Ct + 128 * CSTR, CSTR, Qs + rq * 32 * QSTR, QSTR, 4, lane);
                if (lane < 32) qn[rq * 32 + lane] = aq[0]; }
        }
        else {
        float psum = 0.f;
#pragma unroll 1
        for (int j = 0; j < 2; ++j) { const int st = par * 2 + j;
            if (st <= rb) {
                f32x16 acc;
#pragma unroll
                for (int i = 0; i < 16; ++i) acc[i] = 0.f;
                acc = mma_tile(acc, Ks + st * 32 * KSTR, KSTR, Qs + rb * 32 * QSTR, QSTR, 4, lane);
                const int t = rb * 32 + (lane & 31); const float em = eMt[t];
#pragma unroll
                for (int g4 = 0; g4 < 4; ++g4) { const int s0 = st * 32 + 8 * g4 + 4 * (lane >> 5);
                    const f32x4 ws4 = *(const LAS f32x4*)(wst + s0);
                    float v4[4];
#pragma unroll
                    for (int j = 0; j < 4; ++j) v4[j] = (s0 + j <= t) ? acc[4 * g4 + j] * (ws4[j] * em) : 0.f;
                    psum += (v4[0] + v4[1]) + (v4[2] + v4[3]);
                    u32x2 w; w.x = cvt_pk_bf16(v4[0], v4[1]); w.y = cvt_pk_bf16(v4[2], v4[3]);
                    *(LAS u32x2*)(Ps + t * PSTR + s0) = w; }
            } }
        psum += __shfl_xor(psum, 32);
        if (lane < 32) { if (par == 0) den[rb * 32 + lane] = psum; else if (rb >= 2) den1[rb * 32 + lane] = psum; }
        }
        ML_BAR();
        { const int r = tid & 127; const float ws_ = wst[r];
#pragma unroll
          for (int i = 0; i < 2; ++i) { const int c = (tid >> 7) + 4 * i; const u32x4 x = kreg[i]; LAS bf16_t* kp = Ks + (c * 8) * KWSTR + r;
            kp[0 * KWSTR] = f2bf(bflo(x.x) * ws_); kp[1 * KWSTR] = f2bf(bfhi(x.x) * ws_); kp[2 * KWSTR] = f2bf(bflo(x.y) * ws_); kp[3 * KWSTR] = f2bf(bfhi(x.y) * ws_);
            kp[4 * KWSTR] = f2bf(bflo(x.z) * ws_); kp[5 * KWSTR] = f2bf(bfhi(x.z) * ws_); kp[6 * KWSTR] = f2bf(bflo(x.w) * ws_); kp[7 * KWSTR] = f2bf(bfhi(x.w) * ws_); } }
        if (cc + 1 < 32) ML_LOAD(cc + 1);
        if (cc + 2 < 32) ML_LOADG(cc + 2);
#pragma unroll 1
        for (int j = 0; j < 2; ++j) { const int vt = w & 3, rb2 = (w < 4) ? (j ? 0 : 3) : (j ? 1 : 2);
            f32x16 accn;
#pragma unroll
            for (int i = 0; i < 16; ++i) accn[i] = 0.f;
            accn = mma_tile(accn, Ct + vt * 32 * CSTR, CSTR, Qs + rb2 * 32 * QSTR, QSTR, 4, lane);
            const int t = rb2 * 32 + (lane & 31); const float wi = wint[t];
#pragma unroll
            for (int i = 0; i < 16; ++i) accn[i] *= wi;
            accn = mma_tile(accn, Vt + vt * 32 * VSTR, VSTR, Ps + rb2 * 32 * PSTR, PSTR, (rb2 + 1) * 2, lane);
            const float dsum = den[t] + ((rb2 >= 2) ? den1[t] : 0.f) + wi * qn[t];
            const float rd = __builtin_amdgcn_rcpf(fmaxf(fabsf(dsum), emt[t]));
            bf16_t* ob = hout + (size_t)(tokbase + ML_POS(cc, t)) * 512 + h * 128 + vt * 32 + 4 * (lane >> 5);
#pragma unroll
            for (int g4 = 0; g4 < 4; ++g4) { u32x2 w; w.x = cvt_pk_bf16(accn[4 * g4] * rd, accn[4 * g4 + 1] * rd); w.y = cvt_pk_bf16(accn[4 * g4 + 2] * rd, accn[4 * g4 + 3] * rd);
                *(u32x2*)(ob + 8 * g4) = w; } }
        ML_BAR();
        { const float decay = scal[0];
          { const int vt = w >> 1, dt = w & 1;
#pragma unroll
            for (int i = 0; i < 16; ++i) accC0[i] *= decay;
            accC0 = mma_tile(accC0, Ks + dt * 32 * KWSTR, KWSTR, Vt + vt * 32 * VSTR, VSTR, 8, lane);
            const int v = vt * 32 + (lane & 31);
#pragma unroll
            for (int g4 = 0; g4 < 4; ++g4) { u32x2 w; w.x = cvt_pk_bf16(accC0[4 * g4], accC0[4 * g4 + 1]); w.y = cvt_pk_bf16(accC0[4 * g4 + 2], accC0[4 * g4 + 3]);
                *(LAS u32x2*)(Ct + v * CSTR + dt * 32 + 8 * g4 + 4 * (lane >> 5)) = w; } }
          { const int d = tid >> 3, sl = tid & 7; const LAS bf16_t* kr = Ks + d * KWSTR + sl * 16;
            const u32x4 x = *(const LAS u32x4*)kr, y = *(const LAS u32x4*)(kr + 8);
            float sacc = ((bflo(x.x) + bfhi(x.x)) + (bflo(x.y) + bfhi(x.y))) + ((bflo(x.z) + bfhi(x.z)) + (bflo(x.w) + bfhi(x.w)))
                       + ((bflo(y.x) + bfhi(y.x)) + (bflo(y.y) + bfhi(y.y))) + ((bflo(y.z) + bfhi(y.z)) + (bflo(y.w) + bfhi(y.w)));
            sacc += __shfl_xor(sacc, 1); sacc += __shfl_xor(sacc, 2); sacc += __shfl_xor(sacc, 4);
            nst = nst * decay + sacc; if (sl == 0) Ct[128 * CSTR + d] = f2bf(nst); } }
        ML_BAR();
    }
#undef ML_LOAD
#undef ML_LOADG
#undef ML_PUTG
#undef ML_POS
#undef ML_BAR
#undef ML_PTRS
}
}

__device__ __forceinline__ void s5_scan(const Args& a, int vblk, int nvblk) {
    const float *lam_re = a.in[13], *lam_im = a.in[14], *log_step = a.in[15];
    const float* Sloc = (const float*)(a.ws + WS_SLOC); bf16_t* Ue = (bf16_t*)(a.ws + WS_UEXT);
    for (int gi = vblk * 512 + threadIdx.x; gi < 65536; gi += nvblk * 512) {
        const int p = gi & 63, d = (gi >> 6) & 1, b = (gi >> 7) & 15, g = gi >> 11;
        const float lr = lam_re[(d * 32 + g) * 64 + p], li = lam_im[(d * 32 + g) * 64 + p], step = expf(log_step[d * 32 + g]);
        float ar, ai; cpow(lr, li, step, SL, ar, ai);
        float hr = 0.f, hi = 0.f;
        const float* sl = Sloc + (size_t)(g * SNROW + b * SNCH) * 256 + d * 128 + p;
        bf16_t* ue = Ue + (size_t)(g * SNROW + b * SNCH) * UEXT + UK + d * 128 + p;
        for (int c0 = 0; c0 < SNCH; c0 += 16) {
            float xr[16], xi[16];
#pragma unroll
            for (int u = 0; u < 16; ++u) { const int c = d ? SNCH - 1 - (c0 + u) : c0 + u; xr[u] = sl[(size_t)c * 256]; xi[u] = sl[(size_t)c * 256 + 64]; }
#pragma unroll
            for (int u = 0; u < 16; ++u) { const int c = d ? SNCH - 1 - (c0 + u) : c0 + u; ue[(size_t)c * UEXT] = f2bf(hr); ue[(size_t)c * UEXT + 64] = f2bf(hi);
                const float nr = ar * hr - ai * hi + xr[u], ni = ar * hi + ai * hr + xi[u]; hr = nr; hi = ni; }
        }
    }
}

template <int PART>
__device__ __forceinline__ void phase_mixfin(const Args& a, int vb, int nvb) {
    const int lane = threadIdx.x & 63, gw = vb * 8 + (threadIdx.x >> 6), NGW = nvb * 8;
    const bf16_t* hf = (const bf16_t*)(a.ws + WS_HF); const bf16_t* hb = (const bf16_t*)(a.ws + WS_HB); const bf16_t* og = (const bf16_t*)(a.ws + WS_OG);
    const bf16_t* z = (const bf16_t*)(a.ws + WS_Z); bf16_t* mixed = (bf16_t*)(a.ws + WS_XM);
    const float* ng = a.in[12]; const float* sg = a.in[23];
    for (int row0 = gw * 4; row0 < MTOK; row0 += NGW * 4) {
      u32x4 rf[4], rb_[4], rg[4], rz[4];
#pragma unroll
      for (int r = 0; r < 4; ++r) { const size_t o = (size_t)(row0 + r) * 512 + lane * 8;
          if (PART == 0) { rf[r] = *(const u32x4*)(hf + o); rb_[r] = *(const u32x4*)(hb + o); rg[r] = *(const u32x4*)(og + o); } else rz[r] = *(const u32x4*)(z + o); }
#pragma unroll
      for (int r = 0; r < 4; ++r) { const int row = row0 + r;
        if (PART == 0) {
            const u32x4 f = rf[r], bk = rb_[r], gt = rg[r];
            float v[8];
            v[0] = bflo(gt.x) * (bflo(f.x) + bflo(bk.x)); v[1] = bfhi(gt.x) * (bfhi(f.x) + bfhi(bk.x)); v[2] = bflo(gt.y) * (bflo(f.y) + bflo(bk.y)); v[3] = bfhi(gt.y) * (bfhi(f.y) + bfhi(bk.y));
            v[4] = bflo(gt.z) * (bflo(f.z) + bflo(bk.z)); v[5] = bfhi(gt.z) * (bfhi(f.z) + bfhi(bk.z)); v[6] = bflo(gt.w) * (bflo(f.w) + bflo(bk.w)); v[7] = bfhi(gt.w) * (bfhi(f.w) + bfhi(bk.w));
            float s = 0.f;
#pragma unroll
            for (int j = 0; j < 8; ++j) s += v[j];
#pragma unroll
            for (int of = 1; of < 16; of <<= 1) s += __shfl_xor(s, of);
            const float mu = s * (1.f / 128.f); float s2 = 0.f;
#pragma unroll
            for (int j = 0; j < 8; ++j) { v[j] -= mu; s2 += v[j] * v[j]; }
#pragma unroll
            for (int of = 1; of < 16; of <<= 1) s2 += __shfl_xor(s2, of);
            const float rstd = 1.f / sqrtf(s2 * (1.f / 128.f) + LN_EPS);
            const f32x4 g0 = *(const f32x4*)(ng + lane * 8), g1 = *(const f32x4*)(ng + lane * 8 + 4);
            u32x4 wv; wv.x = cvt_pk_bf16(v[0] * rstd * g0[0], v[1] * rstd * g0[1]); wv.y = cvt_pk_bf16(v[2] * rstd * g0[2], v[3] * rstd * g0[3]);
            wv.z = cvt_pk_bf16(v[4] * rstd * g1[0], v[5] * rstd * g1[1]); wv.w = cvt_pk_bf16(v[6] * rstd * g1[2], v[7] * rstd * g1[3]);
            *(u32x4*)(mixed + (size_t)row * DM + lane * 8) = wv;
        } else {
            const u32x4 zz = rz[r];
            float y[8];
            y[0] = bflo(zz.x); y[1] = bfhi(zz.x); y[2] = bflo(zz.y); y[3] = bfhi(zz.y); y[4] = bflo(zz.z); y[5] = bfhi(zz.z); y[6] = bflo(zz.w); y[7] = bfhi(zz.w);
            float q = 0.f;
#pragma unroll
            for (int j = 0; j < 8; ++j) q += y[j] * y[j];
            q = wave_sum(q);
            const float rr = 1.f / sqrtf(q * (1.f / 512.f) + LN_EPS);
            const f32x4 h0 = *(const f32x4*)(sg + lane * 8), h1 = *(const f32x4*)(sg + lane * 8 + 4);
            u32x4 wz; wz.x = cvt_pk_bf16(y[0] * rr * h0[0], y[1] * rr * h0[1]); wz.y = cvt_pk_bf16(y[2] * rr * h0[2], y[3] * rr * h0[3]);
            wz.z = cvt_pk_bf16(y[4] * rr * h1[0], y[5] * rr * h1[1]); wz.w = cvt_pk_bf16(y[6] * rr * h1[2], y[7] * rr * h1[3]);
            *(u32x4*)(mixed + (size_t)row * DM + 512 + lane * 8) = wz;
        }
      }
    }
}

#define XB_TMO      128
#define XB_XCNT(j)  (256  + 64 * (j))
#define XB_XSUB(j)  (1280 + 64 * (j))
#define XB_XGEN(j)  (2304 + 64 * (j))
#define XB_TOP      3328
#define XB_TOPGEN   3392
#define XCD_BAR_WORDS 3456
#define XB_SPIN_CAP (1u << 20)
__device__ __forceinline__ unsigned xb_ld(unsigned* p)              { return __hip_atomic_load(p, __ATOMIC_RELAXED, __HIP_MEMORY_SCOPE_AGENT); }
__device__ __forceinline__ unsigned xb_add(unsigned* p, unsigned v) { return __hip_atomic_fetch_add(p, v, __ATOMIC_RELAXED, __HIP_MEMORY_SCOPE_AGENT); }
__device__ __forceinline__ unsigned xb_xcc_id() { return (unsigned)__builtin_amdgcn_s_getreg((3 << 11) | 20) & 0xFu; }
#define XB_SPIN(cond, bar) do { unsigned _sp = 0; while (cond) { __builtin_amdgcn_s_sleep(1); \
    if ((++_sp & 255u) == 0u) { if (xb_ld(&(bar)[XB_TMO])) break; if (_sp > XB_SPIN_CAP) { atomicAdd(&(bar)[XB_TMO], 1u); break; } } } } while (0)
struct XcdBarrier { unsigned* bar; unsigned x; volatile LAS unsigned* st; unsigned total; };
__device__ __forceinline__ XcdBarrier xcd_barrier_post(unsigned* bar, volatile LAS unsigned* st, unsigned total) {
    XcdBarrier b; b.bar = bar; b.x = xb_xcc_id(); b.st = st; b.total = total;
    if (threadIdx.x == 0) (void)xb_add(&bar[XB_XCNT(b.x)], 1u);
    return b;
}
__device__ __forceinline__ void xcd_barrier_complete(unsigned* bar, unsigned x, unsigned G, unsigned& nloc, unsigned& nx) {
    unsigned sum, cnt, mine, sp = 0u;
    for (;;) {
        sum = 0u; cnt = 0u; mine = 0u;
#pragma unroll
        for (unsigned j = 0; j < 16; ++j) { const unsigned c = xb_ld(&bar[XB_XCNT(j)]); sum += c; cnt += (c > 0u) ? 1u : 0u; mine = (j == x) ? c : mine; }
        if (sum == G) break;
        __builtin_amdgcn_s_sleep(1);
        if ((++sp & 255u) == 0u) { if (xb_ld(&bar[XB_TMO])) break; if (sp > XB_SPIN_CAP) { atomicAdd(&bar[XB_TMO], 1u); break; } }
    }
    nloc = mine > 0u ? mine : 1u; nx = cnt > 0u ? cnt : 1u;
}
__device__ __forceinline__ void xcd_barrier(const XcdBarrier& b) {
    asm volatile("s_waitcnt vmcnt(0)" ::: "memory");
    __syncthreads();
    if (threadIdx.x == 0) {
        unsigned* bar = b.bar;
        __builtin_amdgcn_s_waitcnt(0);
        unsigned nloc = b.st[0], nx = b.st[1];
        if (nloc == 0u) { xcd_barrier_complete(bar, b.x, b.total, nloc, nx); b.st[0] = nloc; b.st[1] = nx; }
        const unsigned old = xb_add(&bar[XB_XSUB(b.x)], 1u);
        const unsigned gen = old / nloc;
        if (old + 1u == (gen + 1u) * nloc) {
            __builtin_amdgcn_fence(__ATOMIC_RELEASE, "agent");
            asm volatile("s_waitcnt vmcnt(0)" ::: "memory");
            const unsigned og = xb_add(&bar[XB_TOP], 1u);
            const unsigned tg = og / nx;
            if (og + 1u == (tg + 1u) * nx) xb_add(&bar[XB_TOPGEN], 1u);
            else XB_SPIN(xb_ld(&bar[XB_TOPGEN]) == tg, bar);
            __builtin_amdgcn_fence(__ATOMIC_ACQUIRE, "agent");
            xb_add(&bar[XB_XGEN(b.x)], 1u);
            asm volatile("s_waitcnt vmcnt(0)" ::: "memory");
        } else {
            XB_SPIN(xb_ld(&bar[XB_XGEN(b.x)]) == gen, bar);
            __builtin_amdgcn_fence(__ATOMIC_ACQUIRE, "agent");
            asm volatile("s_waitcnt vmcnt(0)" ::: "memory");
        }
    }
    __syncthreads();
}

__device__ __forceinline__ void sub_barrier(unsigned* cnt, unsigned target) {
    asm volatile("s_waitcnt vmcnt(0)" ::: "memory");
    __syncthreads();
    if (threadIdx.x == 0) {
        __builtin_amdgcn_fence(__ATOMIC_RELEASE, "agent");
        asm volatile("s_waitcnt vmcnt(0)" ::: "memory");
        (void)xb_add(cnt, 1u);
        unsigned sp = 0u;
        while (xb_ld(cnt) < target) { __builtin_amdgcn_s_sleep(1); if (++sp > (1u << 24)) break; }
        __builtin_amdgcn_fence(__ATOMIC_ACQUIRE, "agent");
        asm volatile("s_waitcnt vmcnt(0)" ::: "memory");
    }
    __syncthreads();
}

template <bool COOP>
__global__ void __launch_bounds__(512, 2) fwd_kernel(Args a) {
    extern __shared__ __attribute__((aligned(16))) unsigned char lds_raw[];
    LAS unsigned char* lds = (LAS unsigned char*)lds_raw;
    unsigned char* ws = a.ws;
    const int G = gridDim.x;
    const float* mod = (const float*)(ws + WS_MOD);
    bf16_t* XM = (bf16_t*)(ws + WS_XM); bf16_t* HH = (bf16_t*)(ws + WS_H);
    bf16_t* YB = (bf16_t*)a.out;
    bf16_t* Y3 = (bf16_t*)(ws + WS_Y3); f32x2n* ST1 = (f32x2n*)(ws + WS_STAT1); f32x2n* ST2 = (f32x2n*)(ws + WS_STAT2);
    const int lo = a.ph_lo, hi = a.ph_hi;
#define IN(k) (lo <= (k) && (k) < hi)
    XcdBarrier bar; bar.bar = (unsigned*)(ws + WS_BAR); bar.x = 0; bar.st = nullptr; bar.total = 0;
    if (COOP) { volatile LAS unsigned* bst = (volatile LAS unsigned*)(lds + LDS_BYTES - 16);
        if (threadIdx.x < 4) bst[threadIdx.x] = 0u;
        __syncthreads();
        bar = xcd_barrier_post((unsigned*)(ws + WS_BAR), bst, (unsigned)G); }
#define SEAM(k) do { if (COOP) { if ((k) + 1 < hi) { if ((k) == 0) cg::this_grid().sync(); else xcd_barrier(bar); } } else __syncthreads(); } while (0)
    if (IN(0)) { phase0(a, lds); SEAM(0); }
    if (IN(1)) { phase1(a, lds); SEAM(1); }
    if (IN(3)) { pg8::Gemm g{XM, (const bf16_t*)(ws + WS_WUP1), MTOK, NUP, DM, DM, DM, 1 << 20, 0}; pg8::StaticOrder S; S.init(MTOK, NUP, G, blockIdx.x);
                 pg8::EpiSwiglu E{HH}; pg8::gemm_phase(lds, g, S, E); SEAM(3); }
    if (IN(4)) { pg8::Gemm g{HH, (const bf16_t*)(ws + WS_WDN1), MTOK, DM, DFF, DFF, DFF, 1 << 20, 0}; pg8::StaticOrder S; S.init(MTOK, DM, G, blockIdx.x);
                 pg8::EpiResB<0> E{a.in[0], nullptr, nullptr, nullptr, nullptr, YB, mod + 0 * 3072 + 2048, 0.5f}; pg8::gemm_phase(lds, g, S, E); SEAM(4); }
    if (IN(5)) { row_pass_b<false>(YB, ST1, a.in[6], a.in[7], mod, 1, XM, nullptr); SEAM(5); }
    if (IN(6)) { pg8::Gemm g{XM, (const bf16_t*)(ws + WS_WIN), MTOK, NINP, DM, DM, DM, 1 << 20, 0}; pg8::StaticOrder S; S.init(MTOK, NINP, G, blockIdx.x);
                 pg8::EpiWin E{(bf16_t*)(ws + WS_QKR), (bf16_t*)(ws + WS_UEXT), (float*)(ws + WS_GATES), (const float*)(ws + WS_BIN)};
                 pg8::gemm_phase(lds, g, S, E); SEAM(6); }
    if (IN(7)) { phase_conv(a);
                 { pg8::Gemm g{(const bf16_t*)(ws + WS_UEXT), (const bf16_t*)(ws + WS_BT1), 32 * SNROW, 256, UK, UEXT, UK, SNROW / 256, (size_t)256 * UK * 2}; pg8::StaticOrder S; S.init(32 * SNROW, 256, G, blockIdx.x);
                   pg8::EpiF32 E{(float*)(ws + WS_SLOC), 256}; pg8::gemm_phase(lds, g, S, E); }
                 tbuild(a, blockIdx.x, G);
                 SEAM(7); }
    if (IN(8)) { const int half = G / 2;
                 if ((int)blockIdx.x < half) { for (int it = blockIdx.x; it < 128; it += half) { const int dir = it & 1, h = (it >> 1) & 3, b = it >> 3;
                         ml::run((const bf16_t*)(ws + WS_QKC), (const bf16_t*)(ws + WS_V), (const float*)(ws + WS_GATES), (bf16_t*)(ws + (dir ? WS_HB : WS_HF)), b, h, dir, lds); __syncthreads(); } }
                 else { const int vb = blockIdx.x - half, nB = G - half;
                     XcdBarrier barB; barB.bar = nullptr; barB.x = 0; barB.st = nullptr; barB.total = 0;
                     if (COOP) { volatile LAS unsigned* bst2 = (volatile LAS unsigned*)(lds + LDS_BYTES - 32);
                         if (threadIdx.x < 2) bst2[threadIdx.x] = 0u;
                         __syncthreads();
                         barB = xcd_barrier_post((unsigned*)(ws + WS_BAR) + 4096, bst2, (unsigned)nB); }
                     s5_scan(a, vb, nB);
                     if (COOP) xcd_barrier(barB); else __syncthreads();
                     { pg8::Gemm g{(const bf16_t*)(ws + WS_UEXT), (const bf16_t*)(ws + WS_BT2), 32 * SNROW, UK, UEXT, UEXT, UEXT, SNROW / 256, (size_t)UK * UEXT * 2}; pg8::StaticOrder S; S.init(32 * SNROW, UK, nB, vb);
                       pg8::EpiS5Out E{(bf16_t*)(ws + WS_YACT)}; pg8::gemm_phase(lds, g, S, E); }
                     if (COOP) xcd_barrier(barB); else __syncthreads();
                     { pg8::Gemm g{(const bf16_t*)(ws + WS_YACT), (const bf16_t*)(ws + WS_WGLU), MTOK, 512, 512, 512, 512, 1 << 20, 0}; pg8::StaticOrder S; S.init(MTOK, 512, nB, vb);
                       pg8::EpiGlu E{(const bf16_t*)(ws + WS_YACT), (bf16_t*)(ws + WS_Z), a.in[22]}; pg8::gemm_phase(lds, g, S, E); }
                     if (COOP) xcd_barrier(barB); else __syncthreads();
                     phase_mixfin<1>(a, vb, nB); }
                 SEAM(8); }
    if (IN(11)) { phase_mixfin<0>(a, blockIdx.x, G); SEAM(11); }
    if (IN(12)) { pg8::Gemm g{XM, (const bf16_t*)(ws + WS_WOUT), MTOK, DM, DM, DM, DM, 1 << 20, 0}; pg8::StaticOrder S; S.init(MTOK, DM, G, blockIdx.x);
                 pg8::EpiResB<1> E{nullptr, YB, ST1, a.in[6], a.in[7], YB, mod + 1 * 3072 + 2048, 1.0f}; pg8::gemm_phase(lds, g, S, E); SEAM(12); }
    if (IN(13)) { row_pass_b<false>(YB, ST2, a.in[25], a.in[26], mod, 2, XM, nullptr); SEAM(13); }
    if (IN(14)) { pg8::Gemm g{XM, (const bf16_t*)(ws + WS_WUP2), MTOK, NUP, DM, DM, DM, 1 << 20, 0}; pg8::StaticOrder S; S.init(MTOK, NUP, G, blockIdx.x);
                 pg8::EpiSwiglu E{HH}; pg8::gemm_phase(lds, g, S, E); SEAM(14); }
    if (IN(15)) { pg8::Gemm g{HH, (const bf16_t*)(ws + WS_WDN2), MTOK, DM, DFF, DFF, DFF, 1 << 20, 0}; pg8::StaticOrder S; S.init(MTOK, DM, G, blockIdx.x);
                 pg8::EpiResB<1> E{nullptr, YB, ST2, a.in[25], a.in[26], Y3, mod + 2 * 3072 + 2048, 0.5f}; pg8::gemm_phase(lds, g, S, E); SEAM(15); }
    if (IN(16)) { row_pass_b<true>(Y3, nullptr, a.in[29], a.in[30], nullptr, 0, nullptr, a.out); }
#undef IN
#undef SEAM
}

#ifndef MK_ONE_LAUNCH
#define MK_ONE_LAUNCH 1
#endif
extern "C" void kernel_launch(void* const* d_in, const int* in_sizes, int n_in, void* d_out, int out_size, void* d_ws, size_t ws_size, hipStream_t stream) {
    static int grid = 0;
    if (grid == 0) {
        if (n_in != 31 || out_size != MTOK * DM || ws_size < WS_END) { fprintf(stderr, "kernel_launch: unexpected shapes (n_in %d out %d ws %zu)\n", n_in, out_size, ws_size); grid = -1; return; }
        int dev = 0, cus = 0, per_cu = 0;
        (void)hipGetDevice(&dev); (void)hipDeviceGetAttribute(&cus, hipDeviceAttributeMultiprocessorCount, dev);
        (void)hipFuncSetAttribute((const void*)fwd_kernel<true>, hipFuncAttributeMaxDynamicSharedMemorySize, LDS_BYTES);
        (void)hipFuncSetAttribute((const void*)fwd_kernel<false>, hipFuncAttributeMaxDynamicSharedMemorySize, LDS_BYTES);
        (void)hipOccupancyMaxActiveBlocksPerMultiprocessor(&per_cu, (const void*)fwd_kernel<true>, 512, LDS_BYTES);
        if (per_cu < 1) { fprintf(stderr, "kernel_launch: occupancy query says %d blocks per CU\n", per_cu); per_cu = 1; }
        (void)hipGetLastError();
        grid = cus * per_cu;
    }
    if (grid < 0) return;
    Args a{};
    for (int i = 0; i < 31; ++i) a.in[i] = (const float*)d_in[i];
    a.out = (float*)d_out; a.ws = (unsigned char*)d_ws;
#if MK_ONE_LAUNCH
    (void)hipMemsetAsync((char*)d_ws + WS_BAR, 0, BAR_BYTES, stream);
    a.ph_lo = 0; a.ph_hi = NPHASE;
    void* args[] = {&a};
    hipError_t e = hipLaunchCooperativeKernel((const void*)fwd_kernel<true>, dim3(grid), dim3(512), args, LDS_BYTES, stream);
    if (e != hipSuccess) fprintf(stderr, "cooperative launch failed: %s (grid %d)\n", hipGetErrorString(e), grid);
#else
    for (int ph = 0; ph < NPHASE; ++ph) { a.ph_lo = ph; a.ph_hi = ph + 1; hipLaunchKernelGGL(fwd_kernel<false>, dim3(grid), dim3(512), LDS_BYTES, stream, a); }
#endif
}
```

```cpp
#include <hip/hip_runtime.h>
#include <hip/hip_cooperative_groups.h>
#include <cstdio>
namespace cg = cooperative_groups;

#define LAS __attribute__((address_space(3)))
typedef unsigned short bf16_t;
typedef short bf16x8 __attribute__((ext_vector_type(8)));
typedef float f32x4 __attribute__((ext_vector_type(4)));
typedef float f32x16 __attribute__((ext_vector_type(16)));
typedef unsigned u32x4 __attribute__((ext_vector_type(4)));
typedef unsigned u32x2 __attribute__((ext_vector_type(2)));

constexpr int NB = 16, SEQ = 4096, DM = 1024, MTOK = NB * SEQ, DFF = 2816, NUP = 2 * DFF;
constexpr int NIN = 2064, NINP = 2304;
constexpr int MODW = 9216;
constexpr float ALPHA = 1.189207115002721f;
constexpr float LN_EPS = 1e-5f;
constexpr int SL = 32;
constexpr int SNROW = MTOK / SL, SNCH = SEQ / SL, UK = SL * 16;
constexpr int UEXT = UK + 256;
constexpr int LDS_BYTES = 147456;
constexpr int NPHASE = 17;

constexpr size_t MiB = 1u << 20;
constexpr size_t WS_MODP = 278 * MiB  , WS_MOD = 5 * MiB, WS_BIN = 6 * MiB, WS_BAR = 7 * MiB, BAR_BYTES = 32768;
constexpr size_t WS_WUP1 = 8 * MiB, WS_WDN1 = 19 * MiB, WS_WUP2 = 25 * MiB, WS_WDN2 = 36 * MiB;
constexpr size_t WS_WIN = 42 * MiB, WS_WOUT = 47 * MiB, WS_WGLU = 49 * MiB;
constexpr size_t WS_KTAB = 50 * MiB, WS_BT1 = 54 * MiB, WS_BT2 = 70 * MiB;
constexpr size_t WS_XM = 150 * MiB, WS_H = 278 * MiB;
constexpr size_t WS_QKR = 630 * MiB, WS_V = 694 * MiB, WS_OG = 758 * MiB, WS_QKC = 822 * MiB, WS_GATES = 886 * MiB, WS_UEXT = 890 * MiB;
constexpr size_t WS_HF = 278 * MiB, WS_HB = 342 * MiB, WS_SLOC = 406 * MiB  , WS_YACT = 470 * MiB, WS_Z = 534 * MiB;
constexpr size_t WS_STAT1 = 0, WS_STAT2 = 1 * MiB;
constexpr size_t WS_Y3 = 630 * MiB;
constexpr size_t WS_END = 986 * MiB;
static_assert(WS_V == WS_QKR + 64 * MiB && WS_OG == WS_V + 64 * MiB, "q|k, v, o buffers 64 MiB apart");

typedef __bf16 bf16x2n __attribute__((ext_vector_type(2)));
typedef float f32x2n __attribute__((ext_vector_type(2)));
__device__ __forceinline__ unsigned cvt_pk_bf16(float lo, float hi) { const f32x2n v = {lo, hi}; const bf16x2n b = __builtin_convertvector(v, bf16x2n); return __builtin_bit_cast(unsigned, b); }
__device__ __forceinline__ bf16_t f2bf(float f) { const __bf16 b = (__bf16)f; return __builtin_bit_cast(bf16_t, b); }
__device__ __forceinline__ float bf2f(unsigned b) { return __builtin_bit_cast(float, b << 16); }
__device__ __forceinline__ float bflo(unsigned w) { return __builtin_bit_cast(float, w << 16); }
__device__ __forceinline__ float bfhi(unsigned w) { return __builtin_bit_cast(float, w & 0xffff0000u); }
__device__ __forceinline__ float sigmoidf_(float x) { return __builtin_amdgcn_rcpf(1.0f + __builtin_amdgcn_exp2f(-1.4426950408889634f * x)); }
__device__ __forceinline__ float siluf_(float x) { return x * __builtin_amdgcn_rcpf(1.0f + __builtin_amdgcn_exp2f(-1.4426950408889634f * x)); }
__device__ __forceinline__ float gelu_tanh(float x) { const float u = -2.302208198480f * (x + 0.044715f * x * x * x); return x * __builtin_amdgcn_rcpf(1.0f + __builtin_amdgcn_exp2f(u)); }
__device__ __forceinline__ float wave_sum(float v) {
#pragma unroll
    for (int o = 1; o < 64; o <<= 1) v += __shfl_xor(v, o);
    return v;
}
__device__ __forceinline__ void cpow(float lr, float li, float step, int n, float& re, float& im) {
    const float mag = __expf((float)n * lr * step);
    const double th = (double)li * (double)step * (double)n;
    const double k = rint(th * 0.15915494309189535);
    const float r = (float)(th - k * 6.283185307179586);
    re = mag * __cosf(r); im = mag * __sinf(r);
}

namespace pg8 {
constexpr int BM = 256, BK = 64, HALF = 128, HTB = HALF * BK * 2, STAGE_BYTES = 8 * HTB, NXCD = 8, WGM = 8;
__device__ __forceinline__ int lds_byte(int r, int c) { const int st = (r >> 4) * 2 + (c >> 5), rr = r & 15, cc = c & 31, ob = rr * 64 + cc * 2; return st * 1024 + (ob ^ (((ob >> 9) & 1) << 5)); }
__device__ __forceinline__ void stage_rc(int b, int& R, int& C) { const int st = b / 1024, sb = b % 1024, swz = sb ^ (((sb >> 9) & 1) << 5); R = (st >> 1) * 16 + swz / 64; C = (st & 1) * 32 + (swz % 64) / 2; }
__device__ __forceinline__ int perm32(int rho) { const int n = rho >> 4, i = rho & 15; return 8 * (i >> 2) + 4 * n + (i & 3); }

struct Unit { int pm, pn; };
struct Gemm { const bf16_t* A; const bf16_t* Bt; int M, N, K, lda, ldb, mt_per_group; size_t bgroup_bytes; };

struct StaticOrder {
    int nM, nN, nwg, G, c;
    __device__ void init(int M, int N, int G_, int c_) { nM = M / BM; nN = N / BM; nwg = nM * nN; G = G_; c = c_; }
    __device__ bool next(int i, Unit& u) const {
        const long L = (long)i * G + c; if (L >= nwg) return false;
        int wgid = (int)L; { const int q = nwg / NXCD, r = nwg % NXCD, xcd = wgid % NXCD, off = wgid / NXCD; wgid = (xcd < r ? xcd * (q + 1) : r * (q + 1) + (xcd - r) * q) + off; }
        const int nig = WGM * nN, gid = wgid / nig, fm = gid * WGM, gsz = (nM - fm) < WGM ? (nM - fm) : WGM;
        u.pm = fm + ((wgid % nig) % gsz); u.pn = (wgid % nig) / gsz; return true;
    }
};

template <class Epi>
__device__ __forceinline__ void gemm_phase(LAS unsigned char* lds, const Gemm g, const StaticOrder& S, const Epi& E) {
    const int tid = threadIdx.x, wid = __builtin_amdgcn_readfirstlane(tid >> 6), lane = tid & 63, wr = wid >> 2, wc = wid & 3, fr = lane & 15, fq = lane >> 4;
    const int K = g.K, nt = K / BK;
    unsigned voffA[2], voffB[2];
#pragma unroll
    for (int i = 0; i < 2; ++i) { int R, C; stage_rc(tid * 16 + i * 8192, R, C); const int Rb = Epi::PERM ? ((R & ~31) + perm32(R & 31)) : R;
        voffA[i] = (unsigned)(R * g.lda + C) * 2u; voffB[i] = (unsigned)(Rb * g.ldb + C) * 2u; }
    const size_t kstep = (size_t)(BK * 2);
    const size_t hstepA = (size_t)HALF * g.lda * 2, hstepB = (size_t)HALF * g.ldb * 2;
    const size_t tstepA = 2 * hstepA, tstepB = 2 * hstepB;
    const unsigned ldsw = (unsigned)wid * 1024u;
    const int aoff = lds_byte(wr * 64 + fr, fq * 8), boff = lds_byte(wc * 32 + fr, fq * 8);
#define PG8_SA(b, h) (((b) * 2 + (h)) * HTB)
#define PG8_SB(b, h) ((4 + (b) * 2 + (h)) * HTB)
#define PG8_STAGE(bufoff, gbase, voff) do { _Pragma("unroll") for (int _i = 0; _i < 2; ++_i) \
        __builtin_amdgcn_global_load_lds((const unsigned*)((const char*)(gbase) + (voff)[_i]), (LAS unsigned*)(lds + (bufoff) + ldsw + _i * 8192), 16, 0, 0); } while (0)
#define PG8_LDA(dst, b, h) do { _Pragma("unroll") for (int m = 0; m < 4; ++m) _Pragma("unroll") for (int k = 0; k < 2; ++k) dst[m][k] = *(const LAS bf16x8*)(lds + PG8_SA(b, h) + aoff + m * 2048 + k * 1024); } while (0)
#define PG8_LDB(dst, b, h) do { _Pragma("unroll") for (int n = 0; n < 2; ++n) _Pragma("unroll") for (int k = 0; k < 2; ++k) dst[n][k] = *(const LAS bf16x8*)(lds + PG8_SB(b, h) + boff + n * 2048 + k * 1024); } while (0)
#define PG8_MMA(ai, bj, At, Bt) do { __builtin_amdgcn_s_setprio(1); _Pragma("unroll") for (int m = 0; m < 4; ++m) _Pragma("unroll") for (int n = 0; n < 2; ++n) _Pragma("unroll") for (int k = 0; k < 2; ++k) \
        acc[ai][bj][m][n] = __builtin_amdgcn_mfma_f32_16x16x32_bf16(Bt[n][k], At[m][k], acc[ai][bj][m][n], 0, 0, 0); __builtin_amdgcn_s_setprio(0); } while (0)
#define PG8_WAIT_V(n) asm volatile("s_waitcnt vmcnt(" #n ")" ::: "memory")
#define PG8_WAIT_L(n) asm volatile("s_waitcnt lgkmcnt(" #n ")" ::: "memory")
#define PG8_BAR __builtin_amdgcn_s_barrier()
#define PG8_SCHED __builtin_amdgcn_sched_barrier(0)
    Unit cur, nxt; int ui = 0;
    if (!S.next(0, cur)) return;
    f32x4 acc[2][2][4][2];
#pragma unroll
    for (int a = 0; a < 2; ++a)
#pragma unroll
        for (int b = 0; b < 2; ++b)
#pragma unroll
            for (int m = 0; m < 4; ++m)
#pragma unroll
                for (int n = 0; n < 2; ++n) acc[a][b][m][n] = (f32x4){0.f, 0.f, 0.f, 0.f};
    bf16x8 At[4][2], B0[2][2], B1[2][2];
    const char* cA = (const char*)g.A + (size_t)cur.pm * tstepA;
    const char* cB = (const char*)g.Bt + (size_t)(cur.pm / g.mt_per_group) * g.bgroup_bytes + (size_t)cur.pn * tstepB;
    PG8_STAGE(PG8_SB(0, 0), cB, voffB); PG8_STAGE(PG8_SB(0, 1), cB + hstepB, voffB); PG8_STAGE(PG8_SA(0, 0), cA, voffA); PG8_STAGE(PG8_SA(0, 1), cA + hstepA, voffA);
    if (wr == 1) PG8_BAR;
    PG8_WAIT_V(2); PG8_BAR;
    PG8_STAGE(PG8_SB(1, 0), cB + kstep, voffB); PG8_STAGE(PG8_SA(1, 0), cA + kstep, voffA); PG8_STAGE(PG8_SB(1, 1), cB + hstepB + kstep, voffB);
    PG8_WAIT_V(6); PG8_BAR;
    for (;;) {
        const bool has_next = S.next(ui + 1, nxt);
        const char* nA = has_next ? (const char*)g.A + (size_t)nxt.pm * tstepA : cA;
        const char* nB = has_next ? (const char*)g.Bt + (size_t)(nxt.pm / g.mt_per_group) * g.bgroup_bytes + (size_t)nxt.pn * tstepB : cB;
        for (int t = 0; t < nt; t += 2) {
            const bool last = (t == nt - 2);
            const char* a1 = cA + (size_t)(t + 1) * kstep;
            const char* a2 = last ? nA : cA + (size_t)(t + 2) * kstep; const char* b2 = last ? nB : cB + (size_t)(t + 2) * kstep;
            const char* a3 = a2 + kstep; const char* b3 = b2 + kstep;
            PG8_LDB(B0, 0, 0); PG8_LDB(B1, 0, 1); PG8_SCHED; PG8_LDA(At, 0, 0); PG8_STAGE(PG8_SA(1, 1), a1 + hstepA, voffA);
            PG8_WAIT_V(8); PG8_WAIT_L(0); PG8_BAR; PG8_MMA(0, 0, At, B0); PG8_MMA(0, 1, At, B1); PG8_BAR; PG8_SCHED;
            PG8_LDA(At, 0, 1); PG8_STAGE(PG8_SB(0, 0), b2, voffB); PG8_STAGE(PG8_SB(0, 1), b2 + hstepB, voffB); PG8_STAGE(PG8_SA(0, 0), a2, voffA);
            PG8_WAIT_V(8); PG8_WAIT_L(0); PG8_BAR; PG8_MMA(1, 0, At, B0); PG8_MMA(1, 1, At, B1); PG8_BAR; PG8_SCHED;
            PG8_LDB(B0, 1, 0); PG8_LDB(B1, 1, 1); PG8_SCHED; PG8_LDA(At, 1, 0); PG8_STAGE(PG8_SA(0, 1), a2 + hstepA, voffA);
            PG8_WAIT_V(8); PG8_WAIT_L(0); PG8_BAR; PG8_MMA(0, 0, At, B0); PG8_MMA(0, 1, At, B1); PG8_BAR; PG8_SCHED;
            PG8_LDA(At, 1, 1); PG8_STAGE(PG8_SB(1, 0), b3, voffB); PG8_STAGE(PG8_SB(1, 1), b3 + hstepB, voffB); PG8_STAGE(PG8_SA(1, 0), a3, voffA);
            PG8_WAIT_V(8); PG8_WAIT_L(0); PG8_BAR; PG8_MMA(1, 0, At, B0); PG8_MMA(1, 1, At, B1); PG8_BAR; PG8_SCHED;
        }
        if (wr == 0) PG8_BAR;
        E(acc, cur, wr, wc, fr, fq);
        if (!has_next) break;
#pragma unroll
        for (int a = 0; a < 2; ++a)
#pragma unroll
            for (int b = 0; b < 2; ++b)
#pragma unroll
                for (int m = 0; m < 4; ++m)
#pragma unroll
                    for (int n = 0; n < 2; ++n) acc[a][b][m][n] = (f32x4){0.f, 0.f, 0.f, 0.f};
        cur = nxt; cA = nA; cB = nB; ++ui;
        if (wr == 1) PG8_BAR;
    }
    PG8_WAIT_V(0);
    PG8_BAR;
#undef PG8_SA
#undef PG8_SB
#undef PG8_STAGE
#undef PG8_LDA
#undef PG8_LDB
#undef PG8_MMA
#undef PG8_WAIT_V
#undef PG8_WAIT_L
#undef PG8_BAR
#undef PG8_SCHED
}

__device__ __forceinline__ f32x2n swiglu2(f32x2n g, f32x2n u) {
    const f32x2n t = g * -1.4426950408889634f;
    f32x2n e; e.x = __builtin_amdgcn_exp2f(t.x); e.y = __builtin_amdgcn_exp2f(t.y);
    const f32x2n d = e + 1.0f;
    f32x2n r; r.x = __builtin_amdgcn_rcpf(d.x); r.y = __builtin_amdgcn_rcpf(d.y);
    return (g * u) * r;
}
struct EpiSwiglu {
    static constexpr bool PERM = true;
    bf16_t* H;
    __device__ __forceinline__ void operator()(const f32x4 (&acc)[2][2][4][2], const Unit& u, int wr, int wc, int fr, int fq) const {
        const int row0 = u.pm * BM + wr * 64 + fr, col0 = u.pn * 128 + wc * 32 + 8 * fq;
#pragma unroll
        for (int ai = 0; ai < 2; ++ai)
#pragma unroll
            for (int m = 0; m < 4; ++m) {
                const f32x4 g0 = acc[ai][0][m][0], g1 = acc[ai][0][m][1], u0 = acc[ai][1][m][0], u1 = acc[ai][1][m][1];
                const f32x2n a = swiglu2((f32x2n){g0[0], g0[1]}, (f32x2n){u0[0], u0[1]}), b = swiglu2((f32x2n){g0[2], g0[3]}, (f32x2n){u0[2], u0[3]});
                const f32x2n c = swiglu2((f32x2n){g1[0], g1[1]}, (f32x2n){u1[0], u1[1]}), d = swiglu2((f32x2n){g1[2], g1[3]}, (f32x2n){u1[2], u1[3]});
                u32x4 w; w.x = cvt_pk_bf16(a.x, a.y); w.y = cvt_pk_bf16(b.x, b.y); w.z = cvt_pk_bf16(c.x, c.y); w.w = cvt_pk_bf16(d.x, d.y);
                *(u32x4*)(H + (size_t)(row0 + ai * HALF + m * 16) * DFF + col0) = w;
            }
    }
};
struct EpiRes {
    static constexpr bool PERM = false;
    const float* res; float* out; const float* gate; float coef;
    __device__ __forceinline__ void operator()(const f32x4 (&acc)[2][2][4][2], const Unit& u, int wr, int wc, int fr, int fq) const {
        const int row0 = u.pm * BM + wr * 64 + fr, col0 = u.pn * BM + wc * 32 + 4 * fq; const int b = (u.pm * BM) >> 12;
        f32x4 gv[2][2];
#pragma unroll
        for (int bj = 0; bj < 2; ++bj)
#pragma unroll
            for (int n = 0; n < 2; ++n) gv[bj][n] = (*(const f32x4*)(gate + (size_t)b * MODW + col0 + bj * HALF + n * 16) + 1.0f) * coef;
#pragma unroll
        for (int ai = 0; ai < 2; ++ai)
#pragma unroll
            for (int m = 0; m < 4; ++m) { const size_t off = (size_t)(row0 + ai * HALF + m * 16) * DM + col0;
#pragma unroll
                for (int bj = 0; bj < 2; ++bj)
#pragma unroll
                    for (int n = 0; n < 2; ++n) { const f32x4 r = *(const f32x4*)(res + off + bj * HALF + n * 16); *(f32x4*)(out + off + bj * HALF + n * 16) = r * ALPHA + gv[bj][n] * acc[ai][bj][m][n]; }
                asm volatile("" ::: "memory"); }
    }
};
template <int MODE> struct EpiResB {
    static constexpr bool PERM = true;
    const float* resf; const bf16_t* resb; const f32x2n* stats; const float* lng; const float* lnb; bf16_t* out; const float* gate; float coef;
    __device__ __forceinline__ void operator()(const f32x4 (&acc)[2][2][4][2], const Unit& u, int wr, int wc, int fr, int fq) const {
        const int row0 = u.pm * BM + wr * 64 + fr, c8 = u.pn * BM + wc * 32 + 8 * fq; const int b = (u.pm * BM) >> 12;
#pragma unroll
        for (int bj = 0; bj < 2; ++bj) { const int col = c8 + bj * HALF;
            const f32x4 gv0 = (*(const f32x4*)(gate + (size_t)b * MODW + col) + 1.0f) * coef, gv1 = (*(const f32x4*)(gate + (size_t)b * MODW + col + 4) + 1.0f) * coef;
            f32x4 g0, g1, b0, b1;
            if (MODE == 1) { g0 = *(const f32x4*)(lng + col); g1 = *(const f32x4*)(lng + col + 4); b0 = *(const f32x4*)(lnb + col); b1 = *(const f32x4*)(lnb + col + 4); }
#pragma unroll
            for (int ai = 0; ai < 2; ++ai) {
                f32x4 r0[4], r1[4]; u32x4 yv[4]; f32x2n st[4];
#pragma unroll
                for (int m = 0; m < 4; ++m) { const int row = row0 + ai * HALF + m * 16; const size_t off = (size_t)row * DM + col;
                    if (MODE == 0) { r0[m] = *(const f32x4*)(resf + off); r1[m] = *(const f32x4*)(resf + off + 4); }
                    else { yv[m] = *(const u32x4*)(resb + off); st[m] = stats[row]; } }
#pragma unroll
                for (int m = 0; m < 4; ++m) { const int row = row0 + ai * HALF + m * 16; const size_t off = (size_t)row * DM + col;
                    f32x4 x0, x1;
                    if (MODE == 0) { x0 = r0[m]; x1 = r1[m]; }
                    else { const u32x4 y = yv[m];
                        x0 = (f32x4){bflo(y.x), bfhi(y.x), bflo(y.y), bfhi(y.y)}; x1 = (f32x4){bflo(y.z), bfhi(y.z), bflo(y.w), bfhi(y.w)};
                        x0 = (x0 - st[m].x) * st[m].y * g0 + b0; x1 = (x1 - st[m].x) * st[m].y * g1 + b1; }
                    const f32x4 o0 = x0 * ALPHA + gv0 * acc[ai][bj][m][0], o1 = x1 * ALPHA + gv1 * acc[ai][bj][m][1];
                    u32x4 w; w.x = cvt_pk_bf16(o0[0], o0[1]); w.y = cvt_pk_bf16(o0[2], o0[3]); w.z = cvt_pk_bf16(o1[0], o1[1]); w.w = cvt_pk_bf16(o1[2], o1[3]);
                    *(u32x4*)(out + off) = w; }
                asm volatile("" ::: "memory");
            }
        }
    }
};
struct EpiWin {
    static constexpr bool PERM = true;
    bf16_t *QKR, *UE; float* GATES; const float* bias;
    __device__ __forceinline__ void operator()(const f32x4 (&acc)[2][2][4][2], const Unit& u, int wr, int wc, int fr, int fq) const {
        const int c8 = wc * 32 + 8 * fq; const int pn = u.pn;
        if (pn == 8) {
            if (c8 < 16) {
                const f32x4 b0 = *(const f32x4*)(bias + 2048 + c8), b1 = *(const f32x4*)(bias + 2048 + c8 + 4);
#pragma unroll
                for (int ai = 0; ai < 2; ++ai)
#pragma unroll
                    for (int m = 0; m < 4; ++m) { float* gp = GATES + (size_t)(u.pm * BM + wr * 64 + fr + ai * HALF + m * 16) * 16 + c8;
                        *(f32x4*)gp = acc[ai][0][m][0] + b0; *(f32x4*)(gp + 4) = acc[ai][0][m][1] + b1; }
            }
            return;
        }
        bf16_t* base; size_t sa, sm1, sm2, sb;
        if (pn < 6) { bf16_t* buf = QKR + (size_t)(pn >> 1) * (32u << 20); base = buf + (size_t)(u.pm * BM + wr * 64 + fr) * 512 + (pn & 1) * BM + c8; sa = (size_t)HALF * 512; sm1 = 16 * 512; sm2 = 32 * 512; sb = HALF; }
        else { const int ch = (pn - 6) * BM + c8, gq = ch >> 4, hi0 = ch & 15; base = UE + ((size_t)gq * SNROW + u.pm * 8 + wr * 2) * UEXT + fr * 16 + hi0; sa = (size_t)4 * UEXT; sm1 = 256; sm2 = UEXT; sb = (size_t)8 * SNROW * UEXT; }
        const bool sig = (pn == 4 || pn == 5);
#pragma unroll
        for (int bj = 0; bj < 2; ++bj) {
            const f32x4 b0 = *(const f32x4*)(bias + pn * BM + bj * HALF + c8), b1 = *(const f32x4*)(bias + pn * BM + bj * HALF + c8 + 4);
#pragma unroll
            for (int ai = 0; ai < 2; ++ai)
#pragma unroll
                for (int m = 0; m < 4; ++m) { f32x4 v0 = acc[ai][bj][m][0] + b0, v1 = acc[ai][bj][m][1] + b1;
                    if (sig) {
#pragma unroll
                        for (int j = 0; j < 4; ++j) { v0[j] = sigmoidf_(v0[j]); v1[j] = sigmoidf_(v1[j]); } }
                    u32x4 w; w.x = cvt_pk_bf16(v0[0], v0[1]); w.y = cvt_pk_bf16(v0[2], v0[3]); w.z = cvt_pk_bf16(v1[0], v1[1]); w.w = cvt_pk_bf16(v1[2], v1[3]);
                    *(u32x4*)(base + ai * sa + (m & 1) * sm1 + (m >> 1) * sm2 + bj * sb) = w; }
        }
    }
};
struct EpiF32 {
    static constexpr bool PERM = false;
    float* C; int ldc;
    __device__ __forceinline__ void operator()(const f32x4 (&acc)[2][2][4][2], const Unit& u, int wr, int wc, int fr, int fq) const {
        const int row0 = u.pm * BM + wr * 64 + fr, col0 = u.pn * BM + wc * 32 + 4 * fq;
#pragma unroll
        for (int ai = 0; ai < 2; ++ai)
#pragma unroll
            for (int m = 0; m < 4; ++m) { float* rowp = C + (size_t)(row0 + ai * HALF + m * 16) * ldc + col0;
#pragma unroll
                for (int bj = 0; bj < 2; ++bj)
#pragma unroll
                    for (int n = 0; n < 2; ++n) *(f32x4*)(rowp + bj * HALF + n * 16) = acc[ai][bj][m][n]; }
    }
};
struct EpiS5Out {
    static constexpr bool PERM = true;
    bf16_t* Y;
    __device__ __forceinline__ void operator()(const f32x4 (&acc)[2][2][4][2], const Unit& u, int wr, int wc, int fr, int fq) const {
        const int row0 = u.pm * BM + wr * 64 + fr, c8 = u.pn * BM + wc * 32 + 8 * fq;
#pragma unroll
        for (int ai = 0; ai < 2; ++ai)
#pragma unroll
            for (int m = 0; m < 4; ++m) { const int row = row0 + ai * HALF + m * 16, gq = row / SNROW, r = row % SNROW;
#pragma unroll
                for (int bj = 0; bj < 2; ++bj) { const f32x4 v0 = acc[ai][bj][m][0], v1 = acc[ai][bj][m][1]; const int col = c8 + bj * HALF, t = col >> 4, ho0 = col & 15;
                    u32x4 w; w.x = cvt_pk_bf16(gelu_tanh(v0[0]), gelu_tanh(v0[1])); w.y = cvt_pk_bf16(gelu_tanh(v0[2]), gelu_tanh(v0[3]));
                    w.z = cvt_pk_bf16(gelu_tanh(v1[0]), gelu_tanh(v1[1])); w.w = cvt_pk_bf16(gelu_tanh(v1[2]), gelu_tanh(v1[3]));
                    *(u32x4*)(Y + ((size_t)r * SL + t) * 512 + gq * 16 + ho0) = w; } }
    }
};
struct EpiGlu {
    static constexpr bool PERM = true;
    const bf16_t* Y; bf16_t* Z; const float* bias;
    __device__ __forceinline__ void operator()(const f32x4 (&acc)[2][2][4][2], const Unit& u, int wr, int wc, int fr, int fq) const {
        const int row0 = u.pm * BM + wr * 64 + fr, c8 = u.pn * BM + wc * 32 + 8 * fq;
        f32x4 bv[2][2];
#pragma unroll
        for (int bj = 0; bj < 2; ++bj)
#pragma unroll
            for (int n = 0; n < 2; ++n) bv[bj][n] = *(const f32x4*)(bias + c8 + bj * HALF + 4 * n);
#pragma unroll
        for (int ai = 0; ai < 2; ++ai)
#pragma unroll
            for (int m = 0; m < 4; ++m) { const size_t off = (size_t)(row0 + ai * HALF + m * 16) * 512 + c8;
#pragma unroll
                for (int bj = 0; bj < 2; ++bj) { const f32x4 v0 = acc[ai][bj][m][0] + bv[bj][0], v1 = acc[ai][bj][m][1] + bv[bj][1];
                    const u32x4 y = *(const u32x4*)(Y + off + bj * HALF);
                    u32x4 w; w.x = cvt_pk_bf16(bflo(y.x) * sigmoidf_(v0[0]), bfhi(y.x) * sigmoidf_(v0[1])); w.y = cvt_pk_bf16(bflo(y.y) * sigmoidf_(v0[2]), bfhi(y.y) * sigmoidf_(v0[3]));
                    w.z = cvt_pk_bf16(bflo(y.z) * sigmoidf_(v1[0]), bfhi(y.z) * sigmoidf_(v1[1])); w.w = cvt_pk_bf16(bflo(y.w) * sigmoidf_(v1[2]), bfhi(y.w) * sigmoidf_(v1[3]));
                    *(u32x4*)(Z + off + bj * HALF) = w; } }
    }
};
}

struct Args { const float* in[31]; float* out; unsigned char* ws; int ph_lo, ph_hi; };

template <int MODE> __device__ __forceinline__ int dest_row(int n) {
    if (MODE == 1) { if (n < DFF) return (n >> 7) * 256 + (n & 127); n -= DFF; return (n >> 7) * 256 + 128 + (n & 127); }
    if (MODE == 2) { if (n < 1536) return n; if (n < 1552) return 2048 + (n - 1536); return n - 16; }
    return n;
}
template <int MODE> __device__ __forceinline__ void transpose_item(const float* W, int K, int N, bf16_t* WT, LAS float* scr, int item, int lane) {
    const int nblk = (N + 31) / 32, kb = item / nblk, nb = item % nblk, k0 = 64 * kb, n0 = 32 * nb;
    const int nn = n0 + (lane & 31);
    float wl[32];
#pragma unroll
    for (int i = 0; i < 32; ++i) { const int kk = 2 * i + (lane >> 5); wl[i] = (nn < N) ? W[(size_t)(k0 + kk) * N + nn] : 0.f; }
#pragma unroll
    for (int i = 0; i < 32; ++i) { const int kk = 2 * i + (lane >> 5); scr[kk * 33 + (lane & 31)] = wl[i]; }
    asm volatile("s_waitcnt lgkmcnt(0)" ::: "memory");
    const int c = lane & 7;
#pragma unroll
    for (int j = 0; j < 4; ++j) { const int nl = (lane >> 3) + 8 * j; const LAS float* s = scr + (8 * c) * 33 + nl;
        u32x4 o; o.x = cvt_pk_bf16(s[0 * 33], s[1 * 33]); o.y = cvt_pk_bf16(s[2 * 33], s[3 * 33]); o.z = cvt_pk_bf16(s[4 * 33], s[5 * 33]); o.w = cvt_pk_bf16(s[6 * 33], s[7 * 33]);
        if (n0 + nl < N) *(u32x4*)(WT + (size_t)dest_row<MODE>(n0 + nl) * K + k0 + 8 * c) = o; }
    asm volatile("s_waitcnt lgkmcnt(0)" ::: "memory");
}

__device__ __forceinline__ void phase0(const Args& a, LAS unsigned char* lds) {
    const int tid = threadIdx.x, lane = tid & 63, wave = tid >> 6, G = gridDim.x, blk = blockIdx.x;
    unsigned char* ws = a.ws;
    {
        LAS float* sc = (LAS float*)lds;
        const float* c = a.in[1];
        for (int i = tid; i < NB * DM; i += 512) sc[i] = siluf_(c[i]);
        __syncthreads();
        float* modp = (float*)(ws + WS_MODP);
        for (int idx = blk * 512 + tid; idx < MODW * 16; idx += G * 512) {
            const int j = idx % MODW, ks = idx / MODW;
            float acc[16];
#pragma unroll
            for (int b = 0; b < 16; ++b) acc[b] = 0.f;
            const float* w = a.in[2] + (size_t)(ks * 64) * MODW + j;
            const LAS float* scp = sc + ks * 64;
#pragma unroll 1
            for (int k0 = 0; k0 < 64; k0 += 16) { float wv[16];
#pragma unroll
                for (int k = 0; k < 16; ++k) wv[k] = w[(size_t)(k0 + k) * MODW];
#pragma unroll
                for (int k = 0; k < 16; ++k)
#pragma unroll
                    for (int b = 0; b < 16; ++b) acc[b] += scp[b * DM + k0 + k] * wv[k]; }
#pragma unroll
            for (int b = 0; b < 16; ++b) modp[(size_t)(ks * 16 + b) * MODW + j] = acc[b];
        }
        __syncthreads();
    }
    {
        LAS float* Er = (LAS float*)lds; LAS float* Ei = Er + 1024; LAS float* A1r = Ei + 1024; LAS float* A1i = A1r + 1024;
        LAS float* Cr = A1i + 1024; LAS float* Ci = Cr + 1024; LAS float* Br = Ci + 1024; LAS float* Bi = Br + 1024;
        const float *lam_re = a.in[13], *lam_im = a.in[14], *log_step = a.in[15], *b_re = a.in[16], *b_im = a.in[17], *c_re = a.in[18], *c_im = a.in[19];
        float* Ktab = (float*)(ws + WS_KTAB); bf16_t* Bt1 = (bf16_t*)(ws + WS_BT1); bf16_t* Bt2 = (bf16_t*)(ws + WS_BT2);
        for (int it = blk; it < 32 * 2 * (SL / 16); it += G) {
            const int g = it / (2 * (SL / 16)), d = (it / (SL / 16)) & 1, tq = it % (SL / 16);
            for (int e = tid; e < 1024; e += 512) {
                const int tl = e >> 6, p = e & 63, tau = tq * 16 + tl;
                const float lr = lam_re[(d * 32 + g) * 64 + p], li = lam_im[(d * 32 + g) * 64 + p], step = expf(log_step[d * 32 + g]);
                float ar, ai; cpow(lr, li, step, 1, ar, ai);
                const float nr = ar - 1.f, ni = ai, inv = 1.f / (lr * lr + li * li);
                const float cfr = (nr * lr + ni * li) * inv, cfi = (ni * lr - nr * li) * inv;
                float pr, pi; cpow(lr, li, step, tau, pr, pi);
                Er[e] = pr * cfr - pi * cfi; Ei[e] = pr * cfi + pi * cfr;
                float qr, qi; cpow(lr, li, step, tau + 1, qr, qi);
                A1r[e] = qr; A1i[e] = qi;
                Cr[e] = c_re[(size_t)((d * 32 + g) * 16) * 64 + e]; Ci[e] = c_im[(size_t)((d * 32 + g) * 16) * 64 + e];
                Br[e] = b_re[(size_t)g * 1024 + e]; Bi[e] = b_im[(size_t)g * 1024 + e];
            }
            __syncthreads();
            { const int hh = tid & 1, ho = (tid >> 1) & 15, tl = tid >> 5;
              f32x4 s0 = {0.f, 0.f, 0.f, 0.f}, s1 = {0.f, 0.f, 0.f, 0.f};
              for (int p = 0; p < 64; ++p) { const float cr = Cr[ho * 64 + p], ci = Ci[ho * 64 + p], er = Er[tl * 64 + p], ei = Ei[tl * 64 + p];
                  const float cer = cr * er - ci * ei, cei = cr * ei + ci * er;
                  const f32x4 br0 = *(const LAS f32x4*)(Br + p * 16 + hh * 8), br1 = *(const LAS f32x4*)(Br + p * 16 + hh * 8 + 4), bi0 = *(const LAS f32x4*)(Bi + p * 16 + hh * 8), bi1 = *(const LAS f32x4*)(Bi + p * 16 + hh * 8 + 4);
                  s0 += br0 * cer - bi0 * cei; s1 += br1 * cer - bi1 * cei; }
              float* kp = Ktab + (size_t)(((g * 2 + d) * SL) + tq * 16 + tl) * 256 + ho * 16 + hh * 8;
              *(f32x4*)kp = s0; *(f32x4*)(kp + 4) = s1; }
            for (int q = tid; q < 2048; q += 512) {
                const int nl = q & 127, tl = q >> 7, ri = nl >> 6, p = nl & 63, tau = tq * 16 + tl, s = d ? tau : SL - 1 - tau;
                const float er = Er[tl * 64 + p], ei = Ei[tl * 64 + p];
                unsigned w[8];
#pragma unroll
                for (int h2 = 0; h2 < 8; ++h2) { const float br0 = Br[p * 16 + 2 * h2], bi0 = Bi[p * 16 + 2 * h2], br1 = Br[p * 16 + 2 * h2 + 1], bi1 = Bi[p * 16 + 2 * h2 + 1];
                    const float v0 = ri ? (er * bi0 + ei * br0) : (er * br0 - ei * bi0), v1 = ri ? (er * bi1 + ei * br1) : (er * br1 - ei * bi1);
                    w[h2] = cvt_pk_bf16(v0, v1); }
                bf16_t* dst = Bt1 + ((size_t)g * 256 + d * 128 + nl) * UK + s * 16;
                *(u32x4*)dst = (u32x4){w[0], w[1], w[2], w[3]}; *(u32x4*)(dst + 8) = (u32x4){w[4], w[5], w[6], w[7]};
            }
            for (int q = tid; q < 4096; q += 512) {
                const int pg = q & 7, ri = (q >> 3) & 1, ho = (q >> 4) & 15, tl = q >> 8, tau = tq * 16 + tl, t = d ? SL - 1 - tau : tau;
                unsigned w[4];
#pragma unroll
                for (int j2 = 0; j2 < 4; ++j2) { float v[2];
#pragma unroll
                    for (int e2 = 0; e2 < 2; ++e2) { const int p = pg * 8 + j2 * 2 + e2; const float cr = Cr[ho * 64 + p], ci = Ci[ho * 64 + p], qr = A1r[tl * 64 + p], qi = A1i[tl * 64 + p];
                        v[e2] = ri ? -(cr * qi + ci * qr) : (cr * qr - ci * qi); }
                    w[j2] = cvt_pk_bf16(v[0], v[1]); }
                *(u32x4*)(Bt2 + ((size_t)g * UK + t * 16 + ho) * UEXT + UK + d * 128 + ri * 64 + pg * 8) = (u32x4){w[0], w[1], w[2], w[3]};
            }
            __syncthreads();
        }
    }
    {
        LAS float* scr = (LAS float*)(lds + wave * 16384);
        const int gw = blk * 8 + wave, NGW = G * 8;
        constexpr int I_UP = 16 * 176, I_DN = 44 * 32, I_IN = 16 * 65, I_OUT = 16 * 32, I_GLU = 8 * 16;
        constexpr int NITEMS = 2 * I_UP + 2 * I_DN + I_IN + I_OUT + I_GLU;
        for (int it = gw; it < NITEMS; it += NGW) {
            int r = it;
            if (r < I_UP) { transpose_item<1>(a.in[4], DM, NUP, (bf16_t*)(ws + WS_WUP1), scr, r, lane); continue; } r -= I_UP;
            if (r < I_UP) { transpose_item<1>(a.in[27], DM, NUP, (bf16_t*)(ws + WS_WUP2), scr, r, lane); continue; } r -= I_UP;
            if (r < I_DN) { transpose_item<0>(a.in[5], DFF, DM, (bf16_t*)(ws + WS_WDN1), scr, r, lane); continue; } r -= I_DN;
            if (r < I_DN) { transpose_item<0>(a.in[28], DFF, DM, (bf16_t*)(ws + WS_WDN2), scr, r, lane); continue; } r -= I_DN;
            if (r < I_IN) { transpose_item<2>(a.in[8], DM, NIN, (bf16_t*)(ws + WS_WIN), scr, r, lane); continue; } r -= I_IN;
            if (r < I_OUT) { transpose_item<0>(a.in[24], DM, DM, (bf16_t*)(ws + WS_WOUT), scr, r, lane); continue; } r -= I_OUT;
            transpose_item<0>(a.in[21], 512, 512, (bf16_t*)(ws + WS_WGLU), scr, r, lane);
        }
        const int gt = blk * 512 + tid, GT = G * 512;
        u32x4* padp = (u32x4*)((bf16_t*)(ws + WS_WIN) + (size_t)NIN * DM);
        for (int i = gt; i < (NINP - NIN) * DM / 8; i += GT) padp[i] = (u32x4){0u, 0u, 0u, 0u};
        float* binp = (float*)(ws + WS_BIN);
        for (int i = gt; i < NINP; i += GT) { if (i < NIN) binp[dest_row<2>(i)] = a.in[9][i]; else binp[i] = 0.f; }
    }
}

__device__ __forceinline__ void phase1(const Args& a, LAS unsigned char* lds) {
    const int tid = threadIdx.x, lane = tid & 63, wave = tid >> 6, G = gridDim.x;
    const int gt = blockIdx.x * 512 + tid, GT = G * 512;
    unsigned char* ws = a.ws;
    const float* modp = (const float*)(ws + WS_MODP); float* mod = (float*)(ws + WS_MOD); const float* b_ada = a.in[3];
    LAS float* lsh = (LAS float*)lds;
    bf16_t* xm = (bf16_t*)(ws + WS_XM); const float* x = a.in[0];
    for (int rb = blockIdx.x; rb < MTOK / 256; rb += G) {
        const int b = rb >> 4;
        __syncthreads();
        for (int i = tid; i < 2048; i += 512) { float s = b_ada[i];
#pragma unroll
            for (int ks = 0; ks < 16; ++ks) s += modp[(size_t)(ks * 16 + b) * MODW + i];
            lsh[i] = (i >= 1024) ? s + 1.0f : s; }
        __syncthreads();
        f32x4 s0[4], s1[4];
#pragma unroll
        for (int j = 0; j < 4; ++j) { s0[j] = *((const LAS f32x4*)lsh + lane + 64 * j); s1[j] = *((const LAS f32x4*)(lsh + 1024) + lane + 64 * j); }
        for (int it = 0; it < 8; ++it) { const int row0 = rb * 256 + it * 32 + wave * 4;
            f32x4 v[4][4];
#pragma unroll
            for (int r = 0; r < 4; ++r)
#pragma unroll
                for (int j = 0; j < 4; ++j) v[r][j] = __builtin_nontemporal_load((const f32x4*)(x + (size_t)(row0 + r) * DM) + lane + 64 * j);
#pragma unroll
            for (int r = 0; r < 4; ++r)
#pragma unroll
                for (int j = 0; j < 4; ++j) { const f32x4 o = v[r][j] * s1[j] + s0[j]; u32x2 w; w.x = cvt_pk_bf16(o[0], o[1]); w.y = cvt_pk_bf16(o[2], o[3]); *((u32x2*)(xm + (size_t)(row0 + r) * DM) + lane + 64 * j) = w; } }
    }
    for (int i = gt; i < NB * MODW; i += GT) { const int b = i / MODW, j = i % MODW; float s = b_ada[j];
#pragma unroll
        for (int ks = 0; ks < 16; ++ks) s += modp[(size_t)(ks * 16 + b) * MODW + j];
        mod[i] = s; }
}
__device__ __forceinline__ void tbuild(const Args& a, int vb, int nvb) {
    const int gt = vb * 512 + threadIdx.x, GT = nvb * 512;
    unsigned char* ws = a.ws;
    const float* Ktab = (const float*)(ws + WS_KTAB); bf16_t* Bt2 = (bf16_t*)(ws + WS_BT2); const float* dsk = a.in[20];
    constexpr int TB_N = 32 * UK * (UK / 8);
    for (int i0 = gt; i0 < TB_N; i0 += 4 * GT) {
        f32x4 v0[4], v1[4];
#pragma unroll
        for (int u = 0; u < 4; ++u) { const int i = i0 + u * GT; if (i < TB_N) {
            const int kg = i % (UK / 8), n = (i / (UK / 8)) % UK, g = i / ((UK / 8) * UK), t = n >> 4, ho = n & 15, s = kg >> 1, hi0 = (kg & 1) * 8;
            const int dsel = (s > t) ? 1 : 0, lag = (s < t) ? (t - s) : (s - t);
            const float* p = Ktab + (size_t)((g * 2 + dsel) * SL + lag) * 256 + ho * 16 + hi0; v0[u] = *(const f32x4*)p; v1[u] = *(const f32x4*)(p + 4);
            if (s == t) { const float* q = Ktab + (size_t)((g * 2 + 1) * SL) * 256 + ho * 16 + hi0; v0[u] += *(const f32x4*)q; v1[u] += *(const f32x4*)(q + 4);
                const float dd = dsk[g * 16 + ho];
#pragma unroll
                for (int j = 0; j < 4; ++j) { v0[u][j] += (hi0 + j == ho) ? dd : 0.f; v1[u][j] += (hi0 + 4 + j == ho) ? dd : 0.f; } } } }
#pragma unroll
        for (int u = 0; u < 4; ++u) { const int i = i0 + u * GT; if (i < TB_N) {
            const int kg = i % (UK / 8), n = (i / (UK / 8)) % UK, g = i / ((UK / 8) * UK);
            u32x4 w; w.x = cvt_pk_bf16(v0[u][0], v0[u][1]); w.y = cvt_pk_bf16(v0[u][2], v0[u][3]); w.z = cvt_pk_bf16(v1[u][0], v1[u][1]); w.w = cvt_pk_bf16(v1[u][2], v1[u][3]);
            *(u32x4*)(Bt2 + ((size_t)g * UK + n) * UEXT + kg * 8) = w; } }
    }
}

__device__ __forceinline__ void mod_pass(const float* src, const float* mod, int sub, bf16_t* xm) {
    const int lane = threadIdx.x & 63, gw = blockIdx.x * 8 + (threadIdx.x >> 6), NGW = gridDim.x * 8;
    for (int row0 = gw * 4; row0 < MTOK; row0 += NGW * 4) {
        const int b = row0 >> 12;
        f32x4 v[4][4];
#pragma unroll
        for (int r = 0; r < 4; ++r)
#pragma unroll
            for (int j = 0; j < 4; ++j) v[r][j] = *((const f32x4*)(src + (size_t)(row0 + r) * DM) + lane + 64 * j);
        const f32x4* sh = (const f32x4*)(mod + (size_t)b * MODW + sub * 3072) + lane; const f32x4* scl = (const f32x4*)(mod + (size_t)b * MODW + sub * 3072 + 1024) + lane;
#pragma unroll
        for (int j = 0; j < 4; ++j) { const f32x4 s1 = scl[64 * j] + 1.0f, s0 = sh[64 * j];
#pragma unroll
            for (int r = 0; r < 4; ++r) { const f32x4 o = v[r][j] * s1 + s0; u32x2 w; w.x = cvt_pk_bf16(o[0], o[1]); w.y = cvt_pk_bf16(o[2], o[3]); *((u32x2*)(xm + (size_t)(row0 + r) * DM) + lane + 64 * j) = w; } }
    }
}

template <bool FINAL>
__device__ __forceinline__ void row_pass_b(const bf16_t* src, f32x2n* stats, const float* lng, const float* lnb, const float* mod, int sub, bf16_t* xm, float* outf) {
    const int lane = threadIdx.x & 63, gw = blockIdx.x * 8 + (threadIdx.x >> 6), NGW = gridDim.x * 8;
    f32x4 gg[4], bb[4];
#pragma unroll
    for (int j = 0; j < 2; ++j) { gg[2 * j] = *(const f32x4*)(lng + lane * 8 + 512 * j); gg[2 * j + 1] = *(const f32x4*)(lng + lane * 8 + 512 * j + 4);
        bb[2 * j] = *(const f32x4*)(lnb + lane * 8 + 512 * j); bb[2 * j + 1] = *(const f32x4*)(lnb + lane * 8 + 512 * j + 4); }
    for (int row0 = gw * 4; row0 < MTOK; row0 += NGW * 4) {
        const int b = row0 >> 12;
        u32x4 raw[4][2];
#pragma unroll
        for (int r = 0; r < 4; ++r)
#pragma unroll
            for (int j = 0; j < 2; ++j) raw[r][j] = FINAL ? __builtin_nontemporal_load((const u32x4*)(src + (size_t)(row0 + r) * DM + lane * 8 + 512 * j)) : *(const u32x4*)(src + (size_t)(row0 + r) * DM + lane * 8 + 512 * j);
#pragma unroll
        for (int r = 0; r < 4; ++r) { const int row = row0 + r;
            f32x4 v[4];
#pragma unroll
            for (int j = 0; j < 2; ++j) { const u32x4 y = raw[r][j];
                v[2 * j] = (f32x4){bflo(y.x), bfhi(y.x), bflo(y.y), bfhi(y.y)}; v[2 * j + 1] = (f32x4){bflo(y.z), bfhi(y.z), bflo(y.w), bfhi(y.w)}; }
            float s = 0.f;
#pragma unroll
            for (int j = 0; j < 4; ++j) s += (v[j][0] + v[j][1]) + (v[j][2] + v[j][3]);
            const float mean = wave_sum(s) * (1.f / DM); float s2 = 0.f;
#pragma unroll
            for (int j = 0; j < 4; ++j) { const f32x4 d = v[j] - mean; s2 += (d[0] * d[0] + d[1] * d[1]) + (d[2] * d[2] + d[3] * d[3]); }
            const float rstd = 1.f / sqrtf(wave_sum(s2) * (1.f / DM) + LN_EPS);
#pragma unroll
            for (int j = 0; j < 4; ++j) v[j] = (v[j] - mean) * rstd * gg[j] + bb[j];
            if (FINAL) {
#pragma unroll
                for (int j = 0; j < 2; ++j) { float* o = outf + (size_t)row * DM + lane * 8 + 512 * j; *(f32x4*)o = v[2 * j]; *(f32x4*)(o + 4) = v[2 * j + 1]; }
            } else {
                if (lane == 0) stats[row] = (f32x2n){mean, rstd};
                const float* sh = mod + (size_t)b * MODW + sub * 3072 + lane * 8; const float* scl = sh + 1024;
#pragma unroll
                for (int j = 0; j < 2; ++j) { const f32x4 o0 = v[2 * j] * (*(const f32x4*)(scl + 512 * j) + 1.0f) + *(const f32x4*)(sh + 512 * j), o1 = v[2 * j + 1] * (*(const f32x4*)(scl + 512 * j + 4) + 1.0f) + *(const f32x4*)(sh + 512 * j + 4);
                    u32x4 w; w.x = cvt_pk_bf16(o0[0], o0[1]); w.y = cvt_pk_bf16(o0[2], o0[3]); w.z = cvt_pk_bf16(o1[0], o1[1]); w.w = cvt_pk_bf16(o1[2], o1[3]);
                    *(u32x4*)(xm + (size_t)row * DM + lane * 8 + 512 * j) = w; }
            }
        }
    }
}

__device__ __forceinline__ void phase_conv(const Args& a) {
    const int gt = blockIdx.x * 512 + threadIdx.x, GT = gridDim.x * 512;
    const bf16_t* qkr = (const bf16_t*)(a.ws + WS_QKR); bf16_t* qkc = (bf16_t*)(a.ws + WS_QKC); const float* cw = a.in[10]; const float* cb = a.in[11];
    for (int i = gt; i < (MTOK / 4) * 64; i += GT) {
        const int cg8 = i & 63, tok0 = (i >> 6) * 4, pos0 = tok0 & (SEQ - 1), c0 = cg8 * 8;
        u32x4 x[8];
#pragma unroll
        for (int r = 0; r < 8; ++r) { const int pp = pos0 + r - 2; x[r] = (pp >= 0 && pp < SEQ) ? *(const u32x4*)(qkr + (size_t)(tok0 + r - 2) * 512 + c0) : (u32x4){0u, 0u, 0u, 0u}; }
        f32x4 w0[5], w1[5];
#pragma unroll
        for (int jj = 0; jj < 5; ++jj) { w0[jj] = *(const f32x4*)(cw + jj * 512 + c0); w1[jj] = *(const f32x4*)(cw + jj * 512 + c0 + 4); }
        const f32x4 b0 = *(const f32x4*)(cb + c0), b1 = *(const f32x4*)(cb + c0 + 4);
        const float sc = (c0 >= 256) ? 0.125f : 1.0f;
#pragma unroll
        for (int t = 0; t < 4; ++t) {
            f32x4 a0 = b0, a1 = b1;
#pragma unroll
            for (int jj = 0; jj < 5; ++jj) { const u32x4 xv = x[t + jj];
                a0 += (f32x4){bflo(xv.x), bfhi(xv.x), bflo(xv.y), bfhi(xv.y)} * w0[jj]; a1 += (f32x4){bflo(xv.z), bfhi(xv.z), bflo(xv.w), bfhi(xv.w)} * w1[jj]; }
            u32x4 w; w.x = cvt_pk_bf16(siluf_(a0[0]) * sc, siluf_(a0[1]) * sc); w.y = cvt_pk_bf16(siluf_(a0[2]) * sc, siluf_(a0[3]) * sc);
            w.z = cvt_pk_bf16(siluf_(a1[0]) * sc, siluf_(a1[1]) * sc); w.w = cvt_pk_bf16(siluf_(a1[2]) * sc, siluf_(a1[3]) * sc);
            *(u32x4*)(qkc + (size_t)(tok0 + t) * 512 + c0) = w;
        }
    }
}

namespace ml {
constexpr int QS = 0, KS = 18432, VT = 36864, PS = 80384, CT = 115200, SM = 138240;
constexpr int QSTR = 72, KSTR = 72, VSTR = 136, PSTR = 136, CSTR = 72, KWSTR = 136;
template <int KS>
__device__ __forceinline__ f32x16 mma_tile_t(f32x16 acc, const LAS bf16_t* A, int lda, const LAS bf16_t* B, int ldb, int lane) {
    const LAS bf16_t* ap = A + (lane & 31) * lda + (lane >> 5) * 8; const LAS bf16_t* bp = B + (lane & 31) * ldb + (lane >> 5) * 8;
#pragma unroll
    for (int k0 = 0; k0 < KS; k0 += 4) {
        bf16x8 av[4], bv[4];
#pragma unroll
        for (int k = 0; k < 4; ++k) if (k0 + k < KS) { av[k] = *(const LAS bf16x8*)(ap + (k0 + k) * 16); bv[k] = *(const LAS bf16x8*)(bp + (k0 + k) * 16); }
#pragma unroll
        for (int k = 0; k < 4; ++k) if (k0 + k < KS) acc = __builtin_amdgcn_mfma_f32_32x32x16_bf16(av[k], bv[k], acc, 0, 0, 0);
    }
    return acc;
}
__device__ __forceinline__ f32x16 mma_tile(f32x16 acc, const LAS bf16_t* A, int lda, const LAS bf16_t* B, int ldb, int ksteps, int lane) {
    switch (ksteps) {
    case 2: return mma_tile_t<2>(acc, A, lda, B, ldb, lane);
    case 4: return mma_tile_t<4>(acc, A, lda, B, ldb, lane);
    case 6: return mma_tile_t<6>(acc, A, lda, B, ldb, lane);
    default: return mma_tile_t<8>(acc, A, lda, B, ldb, lane);
    }
}
__device__ __forceinline__ float gate_scan(const LAS float* gis, const LAS float* lfs, LAS float* aS, float m_mem, int lane) {
    LAS float* Mt = aS + 128; LAS float* wint = Mt + 128; LAS float* emt = wint + 128; LAS float* wst = emt + 128; LAS float* eM = wst + 128; LAS float* scal = eM + 128;
    const float l0 = lfs[2 * lane], l1 = lfs[2 * lane + 1]; const float ps = l0 + l1; float incl = ps;
#pragma unroll
    for (int o = 1; o < 64; o <<= 1) { const float t = __shfl_up(incl, o); if (lane >= o) incl += t; }
    const float excl = incl - ps, b0 = excl + l0, b1 = excl + ps;
    const float a0 = gis[2 * lane] - b0, a1 = gis[2 * lane + 1] - b1;
    float inclm = fmaxf(a0, a1);
#pragma unroll
    for (int o = 1; o < 64; o <<= 1) { const float t = __shfl_up(inclm, o); if (lane >= o) inclm = fmaxf(inclm, t); }
    float exclm = __shfl_up(inclm, 1); if (lane == 0) exclm = -3.0e38f;
    const float pm0 = fmaxf(exclm, a0), pm1 = fmaxf(pm0, a1);
    const float M0 = fmaxf(m_mem, pm0), M1 = fmaxf(m_mem, pm1);
    aS[2 * lane] = a0; aS[2 * lane + 1] = a1; Mt[2 * lane] = M0; Mt[2 * lane + 1] = M1;
    wint[2 * lane] = __expf(m_mem - M0); wint[2 * lane + 1] = __expf(m_mem - M1);
    emt[2 * lane] = __expf(-(b0 + M0)); emt[2 * lane + 1] = __expf(-(b1 + M1));
    const float Mlast = __shfl(M1, 63), bend = __shfl(b1, 63);
    wst[2 * lane] = __expf(a0 - Mlast); wst[2 * lane + 1] = __expf(a1 - Mlast);
    eM[2 * lane] = __expf(fminf(Mlast - M0, 80.f)); eM[2 * lane + 1] = __expf(fminf(Mlast - M1, 80.f));
    if (lane == 0) scal[0] = __expf(m_mem - Mlast);
    return bend + Mlast;
}
constexpr int SCB = 3136;
__device__ __forceinline__ void run(const bf16_t* qkc, const bf16_t* vbuf, const float* gates, bf16_t* hout, int b, int h, int dir, LAS unsigned char* lds) {
    const int tid = threadIdx.x, lane = tid & 63, w = __builtin_amdgcn_readfirstlane(tid >> 6);
#define ML_PTRS(L, cb) LAS bf16_t* Qs = (LAS bf16_t*)((L) + QS); LAS bf16_t* Ks = (LAS bf16_t*)((L) + KS); LAS bf16_t* Vt = (LAS bf16_t*)((L) + VT); \
    LAS bf16_t* Ps = (LAS bf16_t*)((L) + PS); LAS bf16_t* Ct = (LAS bf16_t*)((L) + CT); \
    LAS float* aS = (LAS float*)((L) + SM + (cb) * SCB); LAS float* Mt = aS + 128; LAS float* wint = Mt + 128; LAS float* emt = wint + 128; LAS float* wst = emt + 128; LAS float* eMt = wst + 128; LAS float* scal = eMt + 128; (void)eMt; \
    LAS float* aSn = (LAS float*)((L) + SM + (1 - (cb)) * SCB); \
    LAS float* den = (LAS float*)((L) + SM + 2 * SCB); LAS float* gis = den + 128; LAS float* lfs = gis + 128; LAS float* den1 = lfs + 128; LAS float* qn = den1 + 128; (void)den1; (void)qn; \
    (void)Qs; (void)Ks; (void)Vt; (void)Ps; (void)Ct; (void)aS; (void)Mt; (void)wint; (void)emt; (void)den; (void)wst; (void)gis; (void)lfs; (void)scal; (void)aSn
    for (int i = tid; i < 160 * CSTR / 2; i += 512) ((LAS unsigned*)(lds + CT))[i] = 0u;
    for (int i = tid; i < 32 * VSTR / 2; i += 512) ((LAS unsigned*)(lds + VT + 128 * VSTR * 2))[i] = (i < VSTR / 2) ? 0x3F803F80u : 0u;
    f32x16 accC0;
#pragma unroll
    for (int i = 0; i < 16; ++i) accC0[i] = 0.f;
    float nst = 0.f;
    float m_mem = 0.f;
    const int tokbase = b * SEQ; const int sgn = dir ? -1 : 1;
    u32x4 qreg[2], kreg[2], vreg[4]; float gi_r = 0.f, gf_r = 0.f;
#define ML_BAR() do { asm volatile("s_waitcnt lgkmcnt(0)" ::: "memory"); __builtin_amdgcn_s_barrier(); asm volatile("" ::: "memory"); } while (0)
#define ML_POS(cc, r) (((dir) ? ((31 - (cc)) * 128 + 127) : ((cc) * 128)) + sgn * (r))
#define ML_LOAD(cc) do { \
    _Pragma("unroll") for (int i = 0; i < 2; ++i) { const int pc = tid + 512 * i, r = pc >> 3, c = pc & 7; qreg[i] = *(const u32x4*)(qkc + (size_t)(tokbase + ML_POS(cc, r)) * 512 + h * 64 + c * 8); } \
    _Pragma("unroll") for (int i = 0; i < 2; ++i) { const int r = tid & 127, c = (tid >> 7) + 4 * i; kreg[i] = *(const u32x4*)(qkc + (size_t)(tokbase + ML_POS(cc, r)) * 512 + 256 + h * 64 + c * 8); } \
    _Pragma("unroll") for (int i = 0; i < 4; ++i) { const int r = tid & 127, c = (tid >> 7) + 4 * i; vreg[i] = *(const u32x4*)(vbuf + (size_t)(tokbase + ML_POS(cc, r)) * 512 + h * 128 + c * 8); } } while (0)
#define ML_LOADG(cc) do { if (tid < 128) { const float* gp = gates + (size_t)(tokbase + ML_POS(cc, tid)) * 16 + dir * 4 + h; gi_r = gp[0]; gf_r = gp[8]; } } while (0)
#define ML_PUTG() do { if (tid < 128) { gis[tid] = gi_r; lfs[tid] = fminf(gf_r, 0.f) - __logf(1.0f + __expf(-fabsf(gf_r))); } } while (0)
    { ML_PTRS(lds, 0);
      ML_LOADG(0); ML_LOAD(0);
      ML_PUTG();
      __syncthreads();
      if (w == 1) m_mem = gate_scan(gis, lfs, aS, m_mem, lane);
      ML_LOADG(1);
      __syncthreads(); }
    for (int cc = 0; cc < 32; ++cc) {
        unsigned zo = 0u; asm volatile("" : "+s"(zo));
        LAS unsigned char* L = lds + zo;
        const int cb = cc & 1;
        ML_PTRS(L, cb);
#pragma unroll
        for (int i = 0; i < 2; ++i) { const int pc = tid + 512 * i, r = pc >> 3, c = pc & 7; *(LAS u32x4*)(Qs + r * QSTR + c * 8) = qreg[i]; }
#pragma unroll
        for (int i = 0; i < 2; ++i) { const int r = tid & 127, c = (tid >> 7) + 4 * i; *(LAS u32x4*)(Ks + r * KSTR + c * 8) = kreg[i]; }
#pragma unroll
        for (int i = 0; i < 4; ++i) { const int r = tid & 127, c = (tid >> 7) + 4 * i; const u32x4 x = vreg[i]; LAS bf16_t* vp = Vt + (c * 8) * VSTR + r;
            vp[0 * VSTR] = (bf16_t)(x.x & 0xffffu); vp[1 * VSTR] = (bf16_t)(x.x >> 16); vp[2 * VSTR] = (bf16_t)(x.y & 0xffffu); vp[3 * VSTR] = (bf16_t)(x.y >> 16);
            vp[4 * VSTR] = (bf16_t)(x.z & 0xffffu); vp[5 * VSTR] = (bf16_t)(x.z >> 16); vp[6 * VSTR] = (bf16_t)(x.w & 0xffffu); vp[7 * VSTR] = (bf16_t)(x.w >> 16); }
        ML_PUTG();
        ML_BAR();
        const int rb = w >> 1, par = w & 1;
        if (w == 1) { if (cc + 1 < 32) m_mem = gate_scan(gis, lfs, aSn, m_mem, lane); }
        else if (w == 3) {
#pragma unroll 1
            for (int rq = 0; rq < 4; ++rq) { f32x16 aq;
#pragma unroll
                for (int i = 0; i < 16; ++i) aq[i] = 0.f;
                aq = mma_tile(aq, Ct + 128 * CSTR, CSTR, Qs + rq * 32 * QSTR, QSTR, 4, lane);
                if (lane < 32) qn[rq * 32 + lane] = aq[0]; }
        }
        else {
        float psum = 0.f;
#pragma unroll 1
        for (int j = 0; j < 2; ++j) { const int st = par * 2 + j;
            if (st <= rb) {
                f32x16 acc;
#pragma unroll
                for (int i = 0; i < 16; ++i) acc[i] = 0.f;
                acc = mma_tile(acc, Ks + st * 32 * KSTR, KSTR, Qs + rb * 32 * QSTR, QSTR, 4, lane);
                const int t = rb * 32 + (lane & 31); const float em = eMt[t];
#pragma unroll
                for (int g4 = 0; g4 < 4; ++g4) { const int s0 = st * 32 + 8 * g4 + 4 * (lane >> 5);
                    const f32x4 ws4 = *(const LAS f32x4*)(wst + s0);
                    float v4[4];
#pragma unroll
                    for (int j = 0; j < 4; ++j) v4[j] = (s0 + j <= t) ? acc[4 * g4 + j] * (ws4[j] * em) : 0.f;
                    psum += (v4[0] + v4[1]) + (v4[2] + v4[3]);
                    u32x2 w; w.x = cvt_pk_bf16(v4[0], v4[1]); w.y = cvt_pk_bf16(v4[2], v4[3]);
                    *(LAS u32x2*)(Ps + t * PSTR + s0) = w; }
            } }
        psum += __shfl_xor(psum, 32);
        if (lane < 32) { if (par == 0) den[rb * 32 + lane] = psum; else if (rb >= 2) den1[rb * 32 + lane] = psum; }
        }
        ML_BAR();
        { const int r = tid & 127; const float ws_ = wst[r];
#pragma unroll
          for (int i = 0; i < 2; ++i) { const int c = (tid >> 7) + 4 * i; const u32x4 x = kreg[i]; LAS bf16_t* kp = Ks + (c * 8) * KWSTR + r;
            kp[0 * KWSTR] = f2bf(bflo(x.x) * ws_); kp[1 * KWSTR] = f2bf(bfhi(x.x) * ws_); kp[2 * KWSTR] = f2bf(bflo(x.y) * ws_); kp[3 * KWSTR] = f2bf(bfhi(x.y) * ws_);
            kp[4 * KWSTR] = f2bf(bflo(x.z) * ws_); kp[5 * KWSTR] = f2bf(bfhi(x.z) * ws_); kp[6 * KWSTR] = f2bf(bflo(x.w) * ws_); kp[7 * KWSTR] = f2bf(bfhi(x.w) * ws_); } }
        if (cc + 1 < 32) ML_LOAD(cc + 1);
        if (cc + 2 < 32) ML_LOADG(cc + 2);
#pragma unroll 1
        for (int j = 0; j < 2; ++j) { const int vt = w & 3, rb2 = (w < 4) ? (j ? 0 : 3) : (j ? 1 : 2);
            f32x16 accn;
#pragma unroll
            for (int i = 0; i < 16; ++i) accn[i] = 0.f;
            accn = mma_tile(accn, Ct + vt * 32 * CSTR, CSTR, Qs + rb2 * 32 * QSTR, QSTR, 4, lane);
            const int t = rb2 * 32 + (lane & 31); const float wi = wint[t];
#pragma unroll
            for (int i = 0; i < 16; ++i) accn[i] *= wi;
            accn = mma_tile(accn, Vt + vt * 32 * VSTR, VSTR, Ps + rb2 * 32 * PSTR, PSTR, (rb2 + 1) * 2, lane);
            const float dsum = den[t] + ((rb2 >= 2) ? den1[t] : 0.f) + wi * qn[t];
            const float rd = __builtin_amdgcn_rcpf(fmaxf(fabsf(dsum), emt[t]));
            bf16_t* ob = hout + (size_t)(tokbase + ML_POS(cc, t)) * 512 + h * 128 + vt * 32 + 4 * (lane >> 5);
#pragma unroll
            for (int g4 = 0; g4 < 4; ++g4) { u32x2 w; w.x = cvt_pk_bf16(accn[4 * g4] * rd, accn[4 * g4 + 1] * rd); w.y = cvt_pk_bf16(accn[4 * g4 + 2] * rd, accn[4 * g4 + 3] * rd);
                *(u32x2*)(ob + 8 * g4) = w; } }
        ML_BAR();
        { const float decay = scal[0];
          { const int vt = w >> 1, dt = w & 1;
#pragma unroll
            for (int i = 0; i < 16; ++i) accC0[i] *= decay;
            accC0 = mma_tile(accC0, Ks + dt * 32 * KWSTR, KWSTR, Vt + vt * 32 * VSTR, VSTR, 8, lane);
            const int v = vt * 32 + (lane & 31);
#pragma unroll
            for (int g4 = 0; g4 < 4; ++g4) { u32x2 w; w.x = cvt_pk_bf16(accC0[4 * g4], accC0[4 * g4 + 1]); w.y = cvt_pk_bf16(accC0[4 * g4 + 2], accC0[4 * g4 + 3]);
                *(LAS u32x2*)(Ct + v * CSTR + dt * 32 + 8 * g4 + 4 * (lane >> 5)) = w; } }
          { const int d = tid >> 3, sl = tid & 7; const LAS bf16_t* kr = Ks + d * KWSTR + sl * 16;
            const u32x4 x = *(const LAS u32x4*)kr, y = *(const LAS u32x4*)(kr + 8);
            float sacc = ((bflo(x.x) + bfhi(x.x)) + (bflo(x.y) + bfhi(x.y))) + ((bflo(x.z) + bfhi(x.z)) + (bflo(x.w) + bfhi(x.w)))
                       + ((bflo(y.x) + bfhi(y.x)) + (bflo(y.y) + bfhi(y.y))) + ((bflo(y.z) + bfhi(y.z)) + (bflo(y.w) + bfhi(y.w)));
            sacc += __shfl_xor(sacc, 1); sacc += __shfl_xor(sacc, 2); sacc += __shfl_xor(sacc, 4);
            nst = nst * decay + sacc; if (sl == 0) Ct[128 * CSTR + d] = f2bf(nst); } }
        ML_BAR();
    }
#undef ML_LOAD
#undef ML_LOADG
#undef ML_PUTG
#undef ML_POS
#undef ML_BAR
#undef ML_PTRS
}
}

__device__ __forceinline__ void s5_scan(const Args& a, int vblk, int nvblk) {
    const float *lam_re = a.in[13], *lam_im = a.in[14], *log_step = a.in[15];
    const float* Sloc = (const float*)(a.ws + WS_SLOC); bf16_t* Ue = (bf16_t*)(a.ws + WS_UEXT);
    for (int gi = vblk * 512 + threadIdx.x; gi < 65536; gi += nvblk * 512) {
        const int p = gi & 63, d = (gi >> 6) & 1, b = (gi >> 7) & 15, g = gi >> 11;
        const float lr = lam_re[(d * 32 + g) * 64 + p], li = lam_im[(d * 32 + g) * 64 + p], step = expf(log_step[d * 32 + g]);
        float ar, ai; cpow(lr, li, step, SL, ar, ai);
        float hr = 0.f, hi = 0.f;
        const float* sl = Sloc + (size_t)(g * SNROW + b * SNCH) * 256 + d * 128 + p;
        bf16_t* ue = Ue + (size_t)(g * SNROW + b * SNCH) * UEXT + UK + d * 128 + p;
        for (int c0 = 0; c0 < SNCH; c0 += 16) {
            float xr[16], xi[16];
#pragma unroll
            for (int u = 0; u < 16; ++u) { const int c = d ? SNCH - 1 - (c0 + u) : c0 + u; xr[u] = sl[(size_t)c * 256]; xi[u] = sl[(size_t)c * 256 + 64]; }
#pragma unroll
            for (int u = 0; u < 16; ++u) { const int c = d ? SNCH - 1 - (c0 + u) : c0 + u; ue[(size_t)c * UEXT] = f2bf(hr); ue[(size_t)c * UEXT + 64] = f2bf(hi);
                const float nr = ar * hr - ai * hi + xr[u], ni = ar * hi + ai * hr + xi[u]; hr = nr; hi = ni; }
        }
    }
}

template <int PART>
__device__ __forceinline__ void phase_mixfin(const Args& a, int vb, int nvb) {
    const int lane = threadIdx.x & 63, gw = vb * 8 + (threadIdx.x >> 6), NGW = nvb * 8;
    const bf16_t* hf = (const bf16_t*)(a.ws + WS_HF); const bf16_t* hb = (const bf16_t*)(a.ws + WS_HB); const bf16_t* og = (const bf16_t*)(a.ws + WS_OG);
    const bf16_t* z = (const bf16_t*)(a.ws + WS_Z); bf16_t* mixed = (bf16_t*)(a.ws + WS_XM);
    const float* ng = a.in[12]; const float* sg = a.in[23];
    for (int row0 = gw * 4; row0 < MTOK; row0 += NGW * 4) {
      u32x4 rf[4], rb_[4], rg[4], rz[4];
#pragma unroll
      for (int r = 0; r < 4; ++r) { const size_t o = (size_t)(row0 + r) * 512 + lane * 8;
          if (PART == 0) { rf[r] = __builtin_nontemporal_load((const u32x4*)(hf + o)); rb_[r] = __builtin_nontemporal_load((const u32x4*)(hb + o)); rg[r] = __builtin_nontemporal_load((const u32x4*)(og + o)); } else rz[r] = __builtin_nontemporal_load((const u32x4*)(z + o)); }
#pragma unroll
      for (int r = 0; r < 4; ++r) { const int row = row0 + r;
        if (PART == 0) {
            const u32x4 f = rf[r], bk = rb_[r], gt = rg[r];
            float v[8];
            v[0] = bflo(gt.x) * (bflo(f.x) + bflo(bk.x)); v[1] = bfhi(gt.x) * (bfhi(f.x) + bfhi(bk.x)); v[2] = bflo(gt.y) * (bflo(f.y) + bflo(bk.y)); v[3] = bfhi(gt.y) * (bfhi(f.y) + bfhi(bk.y));
            v[4] = bflo(gt.z) * (bflo(f.z) + bflo(bk.z)); v[5] = bfhi(gt.z) * (bfhi(f.z) + bfhi(bk.z)); v[6] = bflo(gt.w) * (bflo(f.w) + bflo(bk.w)); v[7] = bfhi(gt.w) * (bfhi(f.w) + bfhi(bk.w));
            float s = 0.f;
#pragma unroll
            for (int j = 0; j < 8; ++j) s += v[j];
#pragma unroll
            for (int of = 1; of < 16; of <<= 1) s += __shfl_xor(s, of);
            const float mu = s * (1.f / 128.f); float s2 = 0.f;
#pragma unroll
            for (int j = 0; j < 8; ++j) { v[j] -= mu; s2 += v[j] * v[j]; }
#pragma unroll
            for (int of = 1; of < 16; of <<= 1) s2 += __shfl_xor(s2, of);
            const float rstd = 1.f / sqrtf(s2 * (1.f / 128.f) + LN_EPS);
            const f32x4 g0 = *(const f32x4*)(ng + lane * 8), g1 = *(const f32x4*)(ng + lane * 8 + 4);
            u32x4 wv; wv.x = cvt_pk_bf16(v[0] * rstd * g0[0], v[1] * rstd * g0[1]); wv.y = cvt_pk_bf16(v[2] * rstd * g0[2], v[3] * rstd * g0[3]);
            wv.z = cvt_pk_bf16(v[4] * rstd * g1[0], v[5] * rstd * g1[1]); wv.w = cvt_pk_bf16(v[6] * rstd * g1[2], v[7] * rstd * g1[3]);
            *(u32x4*)(mixed + (size_t)row * DM + lane * 8) = wv;
        } else {
            const u32x4 zz = rz[r];
            float y[8];
            y[0] = bflo(zz.x); y[1] = bfhi(zz.x); y[2] = bflo(zz.y); y[3] = bfhi(zz.y); y[4] = bflo(zz.z); y[5] = bfhi(zz.z); y[6] = bflo(zz.w); y[7] = bfhi(zz.w);
            float q = 0.f;
#pragma unroll
            for (int j = 0; j < 8; ++j) q += y[j] * y[j];
            q = wave_sum(q);
            const float rr = 1.f / sqrtf(q * (1.f / 512.f) + LN_EPS);
            const f32x4 h0 = *(const f32x4*)(sg + lane * 8), h1 = *(const f32x4*)(sg + lane * 8 + 4);
            u32x4 wz; wz.x = cvt_pk_bf16(y[0] * rr * h0[0], y[1] * rr * h0[1]); wz.y = cvt_pk_bf16(y[2] * rr * h0[2], y[3] * rr * h0[3]);
            wz.z = cvt_pk_bf16(y[4] * rr * h1[0], y[5] * rr * h1[1]); wz.w = cvt_pk_bf16(y[6] * rr * h1[2], y[7] * rr * h1[3]);
            *(u32x4*)(mixed + (size_t)row * DM + 512 + lane * 8) = wz;
        }
      }
    }
}

#define XB_TMO      128
#define XB_XCNT(j)  (256  + 64 * (j))
#define XB_XSUB(j)  (1280 + 64 * (j))
#define XB_XGEN(j)  (2304 + 64 * (j))
#define XB_TOP      3328
#define XB_TOPGEN   3392
#define XCD_BAR_WORDS 3456
#define XB_SPIN_CAP (1u << 20)
__device__ __forceinline__ unsigned xb_ld(unsigned* p)              { return __hip_atomic_load(p, __ATOMIC_RELAXED, __HIP_MEMORY_SCOPE_AGENT); }
__device__ __forceinline__ unsigned xb_add(unsigned* p, unsigned v) { return __hip_atomic_fetch_add(p, v, __ATOMIC_RELAXED, __HIP_MEMORY_SCOPE_AGENT); }
__device__ __forceinline__ unsigned xb_xcc_id() { return (unsigned)__builtin_amdgcn_s_getreg((3 << 11) | 20) & 0xFu; }
#define XB_SPIN(cond, bar) do { unsigned _sp = 0; while (cond) { __builtin_amdgcn_s_sleep(1); \
    if ((++_sp & 255u) == 0u) { if (xb_ld(&(bar)[XB_TMO])) break; if (_sp > XB_SPIN_CAP) { atomicAdd(&(bar)[XB_TMO], 1u); break; } } } } while (0)
struct XcdBarrier { unsigned* bar; unsigned x; volatile LAS unsigned* st; unsigned total; };
__device__ __forceinline__ XcdBarrier xcd_barrier_post(unsigned* bar, volatile LAS unsigned* st, unsigned total) {
    XcdBarrier b; b.bar = bar; b.x = xb_xcc_id(); b.st = st; b.total = total;
    if (threadIdx.x == 0) (void)xb_add(&bar[XB_XCNT(b.x)], 1u);
    return b;
}
__device__ __forceinline__ void xcd_barrier_complete(unsigned* bar, unsigned x, unsigned G, unsigned& nloc, unsigned& nx) {
    unsigned sum, cnt, mine, sp = 0u;
    for (;;) {
        sum = 0u; cnt = 0u; mine = 0u;
#pragma unroll
        for (unsigned j = 0; j < 16; ++j) { const unsigned c = xb_ld(&bar[XB_XCNT(j)]); sum += c; cnt += (c > 0u) ? 1u : 0u; mine = (j == x) ? c : mine; }
        if (sum == G) break;
        __builtin_amdgcn_s_sleep(1);
        if ((++sp & 255u) == 0u) { if (xb_ld(&bar[XB_TMO])) break; if (sp > XB_SPIN_CAP) { atomicAdd(&bar[XB_TMO], 1u); break; } }
    }
    nloc = mine > 0u ? mine : 1u; nx = cnt > 0u ? cnt : 1u;
}
__device__ __forceinline__ void xcd_barrier(const XcdBarrier& b) {
    asm volatile("s_waitcnt vmcnt(0)" ::: "memory");
    __syncthreads();
    if (threadIdx.x == 0) {
        unsigned* bar = b.bar;
        __builtin_amdgcn_s_waitcnt(0);
        unsigned nloc = b.st[0], nx = b.st[1];
        if (nloc == 0u) { xcd_barrier_complete(bar, b.x, b.total, nloc, nx); b.st[0] = nloc; b.st[1] = nx; }
        const unsigned old = xb_add(&bar[XB_XSUB(b.x)], 1u);
        const unsigned gen = old / nloc;
        if (old + 1u == (gen + 1u) * nloc) {
            __builtin_amdgcn_fence(__ATOMIC_RELEASE, "agent");
            asm volatile("s_waitcnt vmcnt(0)" ::: "memory");
            const unsigned og = xb_add(&bar[XB_TOP], 1u);
            const unsigned tg = og / nx;
            if (og + 1u == (tg + 1u) * nx) xb_add(&bar[XB_TOPGEN], 1u);
            else XB_SPIN(xb_ld(&bar[XB_TOPGEN]) == tg, bar);
            __builtin_amdgcn_fence(__ATOMIC_ACQUIRE, "agent");
            xb_add(&bar[XB_XGEN(b.x)], 1u);
            asm volatile("s_waitcnt vmcnt(0)" ::: "memory");
        } else {
            XB_SPIN(xb_ld(&bar[XB_XGEN(b.x)]) == gen, bar);
            __builtin_amdgcn_fence(__ATOMIC_ACQUIRE, "agent");
            asm volatile("s_waitcnt vmcnt(0)" ::: "memory");
        }
    }
    __syncthreads();
}

__device__ __forceinline__ void sub_barrier(unsigned* cnt, unsigned target) {
    asm volatile("s_waitcnt vmcnt(0)" ::: "memory");
    __syncthreads();
    if (threadIdx.x == 0) {
        __builtin_amdgcn_fence(__ATOMIC_RELEASE, "agent");
        asm volatile("s_waitcnt vmcnt(0)" ::: "memory");
        (void)xb_add(cnt, 1u);
        unsigned sp = 0u;
        while (xb_ld(cnt) < target) { __builtin_amdgcn_s_sleep(1); if (++sp > (1u << 24)) break; }
        __builtin_amdgcn_fence(__ATOMIC_ACQUIRE, "agent");
        asm volatile("s_waitcnt vmcnt(0)" ::: "memory");
    }
    __syncthreads();
}

template <bool COOP>
__global__ void __launch_bounds__(512, 2) fwd_kernel(Args a) {
    extern __shared__ __attribute__((aligned(16))) unsigned char lds_raw[];
    LAS unsigned char* lds = (LAS unsigned char*)lds_raw;
    unsigned char* ws = a.ws;
    const int G = gridDim.x;
    const float* mod = (const float*)(ws + WS_MOD);
    bf16_t* XM = (bf16_t*)(ws + WS_XM); bf16_t* HH = (bf16_t*)(ws + WS_H);
    bf16_t* YB = (bf16_t*)a.out;
    bf16_t* Y3 = (bf16_t*)(ws + WS_Y3); f32x2n* ST1 = (f32x2n*)(ws + WS_STAT1); f32x2n* ST2 = (f32x2n*)(ws + WS_STAT2);
    const int lo = a.ph_lo, hi = a.ph_hi;
#define IN(k) (lo <= (k) && (k) < hi)
    XcdBarrier bar; bar.bar = (unsigned*)(ws + WS_BAR); bar.x = 0; bar.st = nullptr; bar.total = 0;
    if (COOP) { volatile LAS unsigned* bst = (volatile LAS unsigned*)(lds + LDS_BYTES - 16);
        if (threadIdx.x < 4) bst[threadIdx.x] = 0u;
        __syncthreads();
        bar = xcd_barrier_post((unsigned*)(ws + WS_BAR), bst, (unsigned)G); }
#define SEAM(k) do { if (COOP) { if ((k) + 1 < hi) { if ((k) == 0) cg::this_grid().sync(); else xcd_barrier(bar); } } else __syncthreads(); } while (0)
    if (IN(0)) { phase0(a, lds); SEAM(0); }
    if (IN(1)) { phase1(a, lds); SEAM(1); }
    if (IN(3)) { pg8::Gemm g{XM, (const bf16_t*)(ws + WS_WUP1), MTOK, NUP, DM, DM, DM, 1 << 20, 0}; pg8::StaticOrder S; S.init(MTOK, NUP, G, blockIdx.x);
                 pg8::EpiSwiglu E{HH}; pg8::gemm_phase(lds, g, S, E); SEAM(3); }
    if (IN(4)) { pg8::Gemm g{HH, (const bf16_t*)(ws + WS_WDN1), MTOK, DM, DFF, DFF, DFF, 1 << 20, 0}; pg8::StaticOrder S; S.init(MTOK, DM, G, blockIdx.x);
                 pg8::EpiResB<0> E{a.in[0], nullptr, nullptr, nullptr, nullptr, YB, mod + 0 * 3072 + 2048, 0.5f}; pg8::gemm_phase(lds, g, S, E); SEAM(4); }
    if (IN(5)) { row_pass_b<false>(YB, ST1, a.in[6], a.in[7], mod, 1, XM, nullptr); SEAM(5); }
    if (IN(6)) { pg8::Gemm g{XM, (const bf16_t*)(ws + WS_WIN), MTOK, NINP, DM, DM, DM, 1 << 20, 0}; pg8::StaticOrder S; S.init(MTOK, NINP, G, blockIdx.x);
                 pg8::EpiWin E{(bf16_t*)(ws + WS_QKR), (bf16_t*)(ws + WS_UEXT), (float*)(ws + WS_GATES), (const float*)(ws + WS_BIN)};
                 pg8::gemm_phase(lds, g, S, E); SEAM(6); }
    if (IN(7)) { phase_conv(a);
                 { pg8::Gemm g{(const bf16_t*)(ws + WS_UEXT), (const bf16_t*)(ws + WS_BT1), 32 * SNROW, 256, UK, UEXT, UK, SNROW / 256, (size_t)256 * UK * 2}; pg8::StaticOrder S; S.init(32 * SNROW, 256, G, blockIdx.x);
                   pg8::EpiF32 E{(float*)(ws + WS_SLOC), 256}; pg8::gemm_phase(lds, g, S, E); }
                 tbuild(a, blockIdx.x, G);
                 SEAM(7); }
    if (IN(8)) { const int half = G / 2;
                 if ((int)blockIdx.x < half) { for (int it = blockIdx.x; it < 128; it += half) { const int dir = it & 1, h = (it >> 1) & 3, b = it >> 3;
                         ml::run((const bf16_t*)(ws + WS_QKC), (const bf16_t*)(ws + WS_V), (const float*)(ws + WS_GATES), (bf16_t*)(ws + (dir ? WS_HB : WS_HF)), b, h, dir, lds); __syncthreads(); } }
                 else { const int vb = blockIdx.x - half, nB = G - half;
                     XcdBarrier barB; barB.bar = nullptr; barB.x = 0; barB.st = nullptr; barB.total = 0;
                     if (COOP) { volatile LAS unsigned* bst2 = (volatile LAS unsigned*)(lds + LDS_BYTES - 32);
                         if (threadIdx.x < 2) bst2[threadIdx.x] = 0u;
                         __syncthreads();
                         barB = xcd_barrier_post((unsigned*)(ws + WS_BAR) + 4096, bst2, (unsigned)nB); }
                     s5_scan(a, vb, nB);
                     if (COOP) xcd_barrier(barB); else __syncthreads();
                     { pg8::Gemm g{(const bf16_t*)(ws + WS_UEXT), (const bf16_t*)(ws + WS_BT2), 32 * SNROW, UK, UEXT, UEXT, UEXT, SNROW / 256, (size_t)UK * UEXT * 2}; pg8::StaticOrder S; S.init(32 * SNROW, UK, nB, vb);
                       pg8::EpiS5Out E{(bf16_t*)(ws + WS_YACT)}; pg8::gemm_phase(lds, g, S, E); }
                     if (COOP) xcd_barrier(barB); else __syncthreads();
                     { pg8::Gemm g{(const bf16_t*)(ws + WS_YACT), (const bf16_t*)(ws + WS_WGLU), MTOK, 512, 512, 512, 512, 1 << 20, 0}; pg8::StaticOrder S; S.init(MTOK, 512, nB, vb);
                       pg8::EpiGlu E{(const bf16_t*)(ws + WS_YACT), (bf16_t*)(ws + WS_Z), a.in[22]}; pg8::gemm_phase(lds, g, S, E); }
                     if (COOP) xcd_barrier(barB); else __syncthreads();
                     phase_mixfin<1>(a, vb, nB); }
                 SEAM(8); }
    if (IN(11)) { phase_mixfin<0>(a, blockIdx.x, G); SEAM(11); }
    if (IN(12)) { pg8::Gemm g{XM, (const bf16_t*)(ws + WS_WOUT), MTOK, DM, DM, DM, DM, 1 << 20, 0}; pg8::StaticOrder S; S.init(MTOK, DM, G, blockIdx.x);
                 pg8::EpiResB<1> E{nullptr, YB, ST1, a.in[6], a.in[7], YB, mod + 1 * 3072 + 2048, 1.0f}; pg8::gemm_phase(lds, g, S, E); SEAM(12); }
    if (IN(13)) { row_pass_b<false>(YB, ST2, a.in[25], a.in[26], mod, 2, XM, nullptr); SEAM(13); }
    if (IN(14)) { pg8::Gemm g{XM, (const bf16_t*)(ws + WS_WUP2), MTOK, NUP, DM, DM, DM, 1 << 20, 0}; pg8::StaticOrder S; S.init(MTOK, NUP, G, blockIdx.x);
                 pg8::EpiSwiglu E{HH}; pg8::gemm_phase(lds, g, S, E); SEAM(14); }
    if (IN(15)) { pg8::Gemm g{HH, (const bf16_t*)(ws + WS_WDN2), MTOK, DM, DFF, DFF, DFF, 1 << 20, 0}; pg8::StaticOrder S; S.init(MTOK, DM, G, blockIdx.x);
                 pg8::EpiResB<1> E{nullptr, YB, ST2, a.in[25], a.in[26], Y3, mod + 2 * 3072 + 2048, 0.5f}; pg8::gemm_phase(lds, g, S, E); SEAM(15); }
    if (IN(16)) { row_pass_b<true>(Y3, nullptr, a.in[29], a.in[30], nullptr, 0, nullptr, a.out); }
#undef IN
#undef SEAM
}

#ifndef MK_ONE_LAUNCH
#define MK_ONE_LAUNCH 1
#endif
extern "C" void kernel_launch(void* const* d_in, const int* in_sizes, int n_in, void* d_out, int out_size, void* d_ws, size_t ws_size, hipStream_t stream) {
    static int grid = 0;
    if (grid == 0) {
        if (n_in != 31 || out_size != MTOK * DM || ws_size < WS_END) { fprintf(stderr, "kernel_launch: unexpected shapes (n_in %d out %d ws %zu)\n", n_in, out_size, ws_size); grid = -1; return; }
        int dev = 0, cus = 0, per_cu = 0;
        (void)hipGetDevice(&dev); (void)hipDeviceGetAttribute(&cus, hipDeviceAttributeMultiprocessorCount, dev);
        (void)hipFuncSetAttribute((const void*)fwd_kernel<true>, hipFuncAttributeMaxDynamicSharedMemorySize, LDS_BYTES);
        (void)hipFuncSetAttribute((const void*)fwd_kernel<false>, hipFuncAttributeMaxDynamicSharedMemorySize, LDS_BYTES);
        (void)hipOccupancyMaxActiveBlocksPerMultiprocessor(&per_cu, (const void*)fwd_kernel<true>, 512, LDS_BYTES);
        if (per_cu < 1) { fprintf(stderr, "kernel_launch: occupancy query says %d blocks per CU\n", per_cu); per_cu = 1; }
        (void)hipGetLastError();
        grid = cus * per_cu;
    }
    if (grid < 0) return;
    Args a{};
    for (int i = 0; i < 31; ++i) a.in[i] = (const float*)d_in[i];
    a.out = (float*)d_out; a.ws = (unsigned char*)d_ws;
#if MK_ONE_LAUNCH
    (void)hipMemsetAsync((char*)d_ws + WS_BAR, 0, BAR_BYTES, stream);
    a.ph_lo = 0; a.ph_hi = NPHASE;
    void* args[] = {&a};
    hipError_t e = hipLaunchCooperativeKernel((const void*)fwd_kernel<true>, dim3(grid), dim3(512), args, LDS_BYTES, stream);
    if (e != hipSuccess) fprintf(stderr, "cooperative launch failed: %s (grid %d)\n", hipGetErrorString(e), grid);
#else
    for (int ph = 0; ph < NPHASE; ++ph) { a.ph_lo = ph; a.ph_hi = ph + 1; hipLaunchKernelGGL(fwd_kernel<false>, dim3(grid), dim3(512), LDS_BYTES, stream, a); }
#endif
}
```

```cpp
#include <hip/hip_runtime.h>
#include <hip/hip_cooperative_groups.h>
#include <cstdio>
namespace cg = cooperative_groups;

#define LAS __attribute__((address_space(3)))
typedef unsigned short bf16_t;
typedef short bf16x8 __attribute__((ext_vector_type(8)));
typedef float f32x4 __attribute__((ext_vector_type(4)));
typedef float f32x16 __attribute__((ext_vector_type(16)));
typedef unsigned u32x4 __attribute__((ext_vector_type(4)));
typedef unsigned u32x2 __attribute__((ext_vector_type(2)));

constexpr int NB = 16, SEQ = 4096, DM = 1024, MTOK = NB * SEQ, DFF = 2816, NUP = 2 * DFF;
constexpr int NIN = 2064, NINP = 2304;
constexpr int MODW = 9216;
constexpr float ALPHA = 1.189207115002721f;
constexpr float LN_EPS = 1e-5f;
constexpr int SL = 32;
constexpr int SNROW = MTOK / SL, SNCH = SEQ / SL, UK = SL * 16;
constexpr int UEXT = UK + 256;
constexpr int LDS_BYTES = 147456;
constexpr int NPHASE = 17;

constexpr size_t MiB = 1u << 20;
constexpr size_t WS_MODP = 278 * MiB  , WS_MOD = 5 * MiB, WS_BIN = 6 * MiB, WS_BAR = 7 * MiB, BAR_BYTES = 32768;
constexpr size_t WS_WUP1 = 8 * MiB, WS_WDN1 = 19 * MiB, WS_WUP2 = 25 * MiB, WS_WDN2 = 36 * MiB;
constexpr size_t WS_WIN = 42 * MiB, WS_WOUT = 47 * MiB, WS_WGLU = 49 * MiB;
constexpr size_t WS_KTAB = 50 * MiB, WS_BT1 = 54 * MiB, WS_BT2 = 70 * MiB;
constexpr size_t WS_XM = 150 * MiB, WS_H = 278 * MiB;
constexpr size_t WS_QKR = 630 * MiB, WS_V = 694 * MiB, WS_OG = 758 * MiB, WS_QKC = 822 * MiB, WS_GATES = 886 * MiB, WS_UEXT = 890 * MiB;
constexpr size_t WS_HF = 278 * MiB, WS_HB = 342 * MiB, WS_SLOC = 406 * MiB  , WS_YACT = 470 * MiB, WS_Z = 534 * MiB;
constexpr size_t WS_STAT1 = 0, WS_STAT2 = 1 * MiB;
constexpr size_t WS_Y3 = 630 * MiB;
constexpr size_t WS_END = 986 * MiB;
static_assert(WS_V == WS_QKR + 64 * MiB && WS_OG == WS_V + 64 * MiB, "q|k, v, o buffers 64 MiB apart");

typedef __bf16 bf16x2n __attribute__((ext_vector_type(2)));
typedef float f32x2n __attribute__((ext_vector_type(2)));
__device__ __forceinline__ unsigned cvt_pk_bf16(float lo, float hi) { const f32x2n v = {lo, hi}; const bf16x2n b = __builtin_convertvector(v, bf16x2n); return __builtin_bit_cast(unsigned, b); }
__device__ __forceinline__ bf16_t f2bf(float f) { const __bf16 b = (__bf16)f; return __builtin_bit_cast(bf16_t, b); }
__device__ __forceinline__ float bf2f(unsigned b) { return __builtin_bit_cast(float, b << 16); }
__device__ __forceinline__ float bflo(unsigned w) { return __builtin_bit_cast(float, w << 16); }
__device__ __forceinline__ float bfhi(unsigned w) { return __builtin_bit_cast(float, w & 0xffff0000u); }
__device__ __forceinline__ float sigmoidf_(float x) { return __builtin_amdgcn_rcpf(1.0f + __builtin_amdgcn_exp2f(-1.4426950408889634f * x)); }
__device__ __forceinline__ float siluf_(float x) { return x * __builtin_amdgcn_rcpf(1.0f + __builtin_amdgcn_exp2f(-1.4426950408889634f * x)); }
__device__ __forceinline__ float gelu_tanh(float x) { const float u = -2.302208198480f * (x + 0.044715f * x * x * x); return x * __builtin_amdgcn_rcpf(1.0f + __builtin_amdgcn_exp2f(u)); }
__device__ __forceinline__ float wave_sum(float v) {
#pragma unroll
    for (int o = 1; o < 64; o <<= 1) v += __shfl_xor(v, o);
    return v;
}
__device__ __forceinline__ void cpow(float lr, float li, float step, int n, float& re, float& im) {
    const float mag = __expf((float)n * lr * step);
    const double th = (double)li * (double)step * (double)n;
    const double k = rint(th * 0.15915494309189535);
    const float r = (float)(th - k * 6.283185307179586);
    re = mag * __cosf(r); im = mag * __sinf(r);
}

namespace pg8 {
constexpr int BM = 256, BK = 64, HALF = 128, HTB = HALF * BK * 2, STAGE_BYTES = 8 * HTB, NXCD = 8, WGM = 8;
__device__ __forceinline__ int lds_byte(int r, int c) { const int st = (r >> 4) * 2 + (c >> 5), rr = r & 15, cc = c & 31, ob = rr * 64 + cc * 2; return st * 1024 + (ob ^ (((ob >> 9) & 1) << 5)); }
__device__ __forceinline__ void stage_rc(int b, int& R, int& C) { const int st = b / 1024, sb = b % 1024, swz = sb ^ (((sb >> 9) & 1) << 5); R = (st >> 1) * 16 + swz / 64; C = (st & 1) * 32 + (swz % 64) / 2; }
__device__ __forceinline__ int perm32(int rho) { const int n = rho >> 4, i = rho & 15; return 8 * (i >> 2) + 4 * n + (i & 3); }

struct Unit { int pm, pn; };
struct Gemm { const bf16_t* A; const bf16_t* Bt; int M, N, K, lda, ldb, mt_per_group; size_t bgroup_bytes; };

struct StaticOrder {
    int nM, nN, nwg, G, c;
    __device__ void init(int M, int N, int G_, int c_) { nM = M / BM; nN = N / BM; nwg = nM * nN; G = G_; c = c_; }
    __device__ bool next(int i, Unit& u) const {
        const long L = (long)i * G + c; if (L >= nwg) return false;
        int wgid = (int)L; { const int q = nwg / NXCD, r = nwg % NXCD, xcd = wgid % NXCD, off = wgid / NXCD; wgid = (xcd < r ? xcd * (q + 1) : r * (q + 1) + (xcd - r) * q) + off; }
        const int nig = WGM * nN, gid = wgid / nig, fm = gid * WGM, gsz = (nM - fm) < WGM ? (nM - fm) : WGM;
        u.pm = fm + ((wgid % nig) % gsz); u.pn = (wgid % nig) / gsz; return true;
    }
};

template <class Epi>
__device__ __forceinline__ void gemm_phase(LAS unsigned char* lds, const Gemm g, const StaticOrder& S, const Epi& E) {
    const int tid = threadIdx.x, wid = __builtin_amdgcn_readfirstlane(tid >> 6), lane = tid & 63, wr = wid >> 2, wc = wid & 3, fr = lane & 15, fq = lane >> 4;
    const int K = g.K, nt = K / BK;
    unsigned voffA[2], voffB[2];
#pragma unroll
    for (int i = 0; i < 2; ++i) { int R, C; stage_rc(tid * 16 + i * 8192, R, C); const int Rb = Epi::PERM ? ((R & ~31) + perm32(R & 31)) : R;
        voffA[i] = (unsigned)(R * g.lda + C) * 2u; voffB[i] = (unsigned)(Rb * g.ldb + C) * 2u; }
    const size_t kstep = (size_t)(BK * 2);
    const size_t hstepA = (size_t)HALF * g.lda * 2, hstepB = (size_t)HALF * g.ldb * 2;
    const size_t tstepA = 2 * hstepA, tstepB = 2 * hstepB;
    const unsigned ldsw = (unsigned)wid * 1024u;
    const int aoff = lds_byte(wr * 64 + fr, fq * 8), boff = lds_byte(wc * 32 + fr, fq * 8);
#define PG8_SA(b, h) (((b) * 2 + (h)) * HTB)
#define PG8_SB(b, h) ((4 + (b) * 2 + (h)) * HTB)
#define PG8_STAGE(bufoff, gbase, voff) do { _Pragma("unroll") for (int _i = 0; _i < 2; ++_i) \
        __builtin_amdgcn_global_load_lds((const unsigned*)((const char*)(gbase) + (voff)[_i]), (LAS unsigned*)(lds + (bufoff) + ldsw + _i * 8192), 16, 0, 0); } while (0)
#define PG8_LDA(dst, b, h) do { _Pragma("unroll") for (int m = 0; m < 4; ++m) _Pragma("unroll") for (int k = 0; k < 2; ++k) dst[m][k] = *(const LAS bf16x8*)(lds + PG8_SA(b, h) + aoff + m * 2048 + k * 1024); } while (0)
#define PG8_LDB(dst, b, h) do { _Pragma("unroll") for (int n = 0; n < 2; ++n) _Pragma("unroll") for (int k = 0; k < 2; ++k) dst[n][k] = *(const LAS bf16x8*)(lds + PG8_SB(b, h) + boff + n * 2048 + k * 1024); } while (0)
#define PG8_MMA(ai, bj, At, Bt) do { __builtin_amdgcn_s_setprio(1); _Pragma("unroll") for (int m = 0; m < 4; ++m) _Pragma("unroll") for (int n = 0; n < 2; ++n) _Pragma("unroll") for (int k = 0; k < 2; ++k) \
        acc[ai][bj][m][n] = __builtin_amdgcn_mfma_f32_16x16x32_bf16(Bt[n][k], At[m][k], acc[ai][bj][m][n], 0, 0, 0); __builtin_amdgcn_s_setprio(0); } while (0)
#define PG8_WAIT_V(n) asm volatile("s_waitcnt vmcnt(" #n ")" ::: "memory")
#define PG8_WAIT_L(n) asm volatile("s_waitcnt lgkmcnt(" #n ")" ::: "memory")
#define PG8_BAR __builtin_amdgcn_s_barrier()
#define PG8_SCHED __builtin_amdgcn_sched_barrier(0)
    Unit cur, nxt; int ui = 0;
    if (!S.next(0, cur)) return;
    f32x4 acc[2][2][4][2];
#pragma unroll
    for (int a = 0; a < 2; ++a)
#pragma unroll
        for (int b = 0; b < 2; ++b)
#pragma unroll
            for (int m = 0; m < 4; ++m)
#pragma unroll
                for (int n = 0; n < 2; ++n) acc[a][b][m][n] = (f32x4){0.f, 0.f, 0.f, 0.f};
    bf16x8 At[4][2], B0[2][2], B1[2][2];
    const char* cA = (const char*)g.A + (size_t)cur.pm * tstepA;
    const char* cB = (const char*)g.Bt + (size_t)(cur.pm / g.mt_per_group) * g.bgroup_bytes + (size_t)cur.pn * tstepB;
    PG8_STAGE(PG8_SB(0, 0), cB, voffB); PG8_STAGE(PG8_SB(0, 1), cB + hstepB, voffB); PG8_STAGE(PG8_SA(0, 0), cA, voffA); PG8_STAGE(PG8_SA(0, 1), cA + hstepA, voffA);
    if (wr == 1) PG8_BAR;
    PG8_WAIT_V(2); PG8_BAR;
    PG8_STAGE(PG8_SB(1, 0), cB + kstep, voffB); PG8_STAGE(PG8_SA(1, 0), cA + kstep, voffA); PG8_STAGE(PG8_SB(1, 1), cB + hstepB + kstep, voffB);
    PG8_WAIT_V(6); PG8_BAR;
    for (;;) {
        const bool has_next = S.next(ui + 1, nxt);
        const char* nA = has_next ? (const char*)g.A + (size_t)nxt.pm * tstepA : cA;
        const char* nB = has_next ? (const char*)g.Bt + (size_t)(nxt.pm / g.mt_per_group) * g.bgroup_bytes + (size_t)nxt.pn * tstepB : cB;
        for (int t = 0; t < nt; t += 2) {
            const bool last = (t == nt - 2);
            const char* a1 = cA + (size_t)(t + 1) * kstep;
            const char* a2 = last ? nA : cA + (size_t)(t + 2) * kstep; const char* b2 = last ? nB : cB + (size_t)(t + 2) * kstep;
            const char* a3 = a2 + kstep; const char* b3 = b2 + kstep;
            PG8_LDB(B0, 0, 0); PG8_LDB(B1, 0, 1); PG8_SCHED; PG8_LDA(At, 0, 0); PG8_STAGE(PG8_SA(1, 1), a1 + hstepA, voffA);
            PG8_WAIT_V(8); PG8_WAIT_L(0); PG8_BAR; PG8_MMA(0, 0, At, B0); PG8_MMA(0, 1, At, B1); PG8_BAR; PG8_SCHED;
            PG8_LDA(At, 0, 1); PG8_STAGE(PG8_SB(0, 0), b2, voffB); PG8_STAGE(PG8_SB(0, 1), b2 + hstepB, voffB); PG8_STAGE(PG8_SA(0, 0), a2, voffA);
            PG8_WAIT_V(8); PG8_WAIT_L(0); PG8_BAR; PG8_MMA(1, 0, At, B0); PG8_MMA(1, 1, At, B1); PG8_BAR; PG8_SCHED;
            PG8_LDB(B0, 1, 0); PG8_LDB(B1, 1, 1); PG8_SCHED; PG8_LDA(At, 1, 0); PG8_STAGE(PG8_SA(0, 1), a2 + hstepA, voffA);
            PG8_WAIT_V(8); PG8_WAIT_L(0); PG8_BAR; PG8_MMA(0, 0, At, B0); PG8_MMA(0, 1, At, B1); PG8_BAR; PG8_SCHED;
            PG8_LDA(At, 1, 1); PG8_STAGE(PG8_SB(1, 0), b3, voffB); PG8_STAGE(PG8_SB(1, 1), b3 + hstepB, voffB); PG8_STAGE(PG8_SA(1, 0), a3, voffA);
            PG8_WAIT_V(8); PG8_WAIT_L(0); PG8_BAR; PG8_MMA(1, 0, At, B0); PG8_MMA(1, 1, At, B1); PG8_BAR; PG8_SCHED;
        }
        if (wr == 0) PG8_BAR;
        E(acc, cur, wr, wc, fr, fq);
        if (!has_next) break;
#pragma unroll
        for (int a = 0; a < 2; ++a)
#pragma unroll
            for (int b = 0; b < 2; ++b)
#pragma unroll
                for (int m = 0; m < 4; ++m)
#pragma unroll
                    for (int n = 0; n < 2; ++n) acc[a][b][m][n] = (f32x4){0.f, 0.f, 0.f, 0.f};
        cur = nxt; cA = nA; cB = nB; ++ui;
        if (wr == 1) PG8_BAR;
    }
    PG8_WAIT_V(0);
    PG8_BAR;
#undef PG8_SA
#undef PG8_SB
#undef PG8_STAGE
#undef PG8_LDA
#undef PG8_LDB
#undef PG8_MMA
#undef PG8_WAIT_V
#undef PG8_WAIT_L
#undef PG8_BAR
#undef PG8_SCHED
}

__device__ __forceinline__ f32x2n swiglu2(f32x2n g, f32x2n u) {
    const f32x2n t = g * -1.4426950408889634f;
    f32x2n e; e.x = __builtin_amdgcn_exp2f(t.x); e.y = __builtin_amdgcn_exp2f(t.y);
    const f32x2n d = e + 1.0f;
    f32x2n r; r.x = __builtin_amdgcn_rcpf(d.x); r.y = __builtin_amdgcn_rcpf(d.y);
    return (g * u) * r;
}
struct EpiSwiglu {
    static constexpr bool PERM = true;
    bf16_t* H;
    __device__ __forceinline__ void operator()(const f32x4 (&acc)[2][2][4][2], const Unit& u, int wr, int wc, int fr, int fq) const {
        const int row0 = u.pm * BM + wr * 64 + fr, col0 = u.pn * 128 + wc * 32 + 8 * fq;
#pragma unroll
        for (int ai = 0; ai < 2; ++ai)
#pragma unroll
            for (int m = 0; m < 4; ++m) {
                const f32x4 g0 = acc[ai][0][m][0], g1 = acc[ai][0][m][1], u0 = acc[ai][1][m][0], u1 = acc[ai][1][m][1];
                const f32x2n a = swiglu2((f32x2n){g0[0], g0[1]}, (f32x2n){u0[0], u0[1]}), b = swiglu2((f32x2n){g0[2], g0[3]}, (f32x2n){u0[2], u0[3]});
                const f32x2n c = swiglu2((f32x2n){g1[0], g1[1]}, (f32x2n){u1[0], u1[1]}), d = swiglu2((f32x2n){g1[2], g1[3]}, (f32x2n){u1[2], u1[3]});
                u32x4 w; w.x = cvt_pk_bf16(a.x, a.y); w.y = cvt_pk_bf16(b.x, b.y); w.z = cvt_pk_bf16(c.x, c.y); w.w = cvt_pk_bf16(d.x, d.y);
                *(u32x4*)(H + (size_t)(row0 + ai * HALF + m * 16) * DFF + col0) = w;
            }
    }
};
struct EpiRes {
    static constexpr bool PERM = false;
    const float* res; float* out; const float* gate; float coef;
    __device__ __forceinline__ void operator()(const f32x4 (&acc)[2][2][4][2], const Unit& u, int wr, int wc, int fr, int fq) const {
        const int row0 = u.pm * BM + wr * 64 + fr, col0 = u.pn * BM + wc * 32 + 4 * fq; const int b = (u.pm * BM) >> 12;
        f32x4 gv[2][2];
#pragma unroll
        for (int bj = 0; bj < 2; ++bj)
#pragma unroll
            for (int n = 0; n < 2; ++n) gv[bj][n] = (*(const f32x4*)(gate + (size_t)b * MODW + col0 + bj * HALF + n * 16) + 1.0f) * coef;
#pragma unroll
        for (int ai = 0; ai < 2; ++ai)
#pragma unroll
            for (int m = 0; m < 4; ++m) { const size_t off = (size_t)(row0 + ai * HALF + m * 16) * DM + col0;
#pragma unroll
                for (int bj = 0; bj < 2; ++bj)
#pragma unroll
                    for (int n = 0; n < 2; ++n) { const f32x4 r = *(const f32x4*)(res + off + bj * HALF + n * 16); *(f32x4*)(out + off + bj * HALF + n * 16) = r * ALPHA + gv[bj][n] * acc[ai][bj][m][n]; }
                asm volatile("" ::: "memory"); }
    }
};
template <int MODE> struct EpiResB {
    static constexpr bool PERM = true;
    const float* resf; const bf16_t* resb; const f32x2n* stats; const float* lng; const float* lnb; bf16_t* out; const float* gate; float coef;
    __device__ __forceinline__ void operator()(const f32x4 (&acc)[2][2][4][2], const Unit& u, int wr, int wc, int fr, int fq) const {
        const int row0 = u.pm * BM + wr * 64 + fr, c8 = u.pn * BM + wc * 32 + 8 * fq; const int b = (u.pm * BM) >> 12;
#pragma unroll
        for (int bj = 0; bj < 2; ++bj) { const int col = c8 + bj * HALF;
            const f32x4 gv0 = (*(const f32x4*)(gate + (size_t)b * MODW + col) + 1.0f) * coef, gv1 = (*(const f32x4*)(gate + (size_t)b * MODW + col + 4) + 1.0f) * coef;
            f32x4 g0, g1, b0, b1;
            if (MODE == 1) { g0 = *(const f32x4*)(lng + col); g1 = *(const f32x4*)(lng + col + 4); b0 = *(const f32x4*)(lnb + col); b1 = *(const f32x4*)(lnb + col + 4); }
#pragma unroll
            for (int ai = 0; ai < 2; ++ai) {
                f32x4 r0[4], r1[4]; u32x4 yv[4]; f32x2n st[4];
#pragma unroll
                for (int m = 0; m < 4; ++m) { const int row = row0 + ai * HALF + m * 16; const size_t off = (size_t)row * DM + col;
                    if (MODE == 0) { r0[m] = __builtin_nontemporal_load((const f32x4*)(resf + off)); r1[m] = __builtin_nontemporal_load((const f32x4*)(resf + off + 4)); }
                    else { yv[m] = *(const u32x4*)(resb + off); st[m] = stats[row]; } }
#pragma unroll
                for (int m = 0; m < 4; ++m) { const int row = row0 + ai * HALF + m * 16; const size_t off = (size_t)row * DM + col;
                    f32x4 x0, x1;
                    if (MODE == 0) { x0 = r0[m]; x1 = r1[m]; }
                    else { const u32x4 y = yv[m];
                        x0 = (f32x4){bflo(y.x), bfhi(y.x), bflo(y.y), bfhi(y.y)}; x1 = (f32x4){bflo(y.z), bfhi(y.z), bflo(y.w), bfhi(y.w)};
                        x0 = (x0 - st[m].x) * st[m].y * g0 + b0; x1 = (x1 - st[m].x) * st[m].y * g1 + b1; }
                    const f32x4 o0 = x0 * ALPHA + gv0 * acc[ai][bj][m][0], o1 = x1 * ALPHA + gv1 * acc[ai][bj][m][1];
                    u32x4 w; w.x = cvt_pk_bf16(o0[0], o0[1]); w.y = cvt_pk_bf16(o0[2], o0[3]); w.z = cvt_pk_bf16(o1[0], o1[1]); w.w = cvt_pk_bf16(o1[2], o1[3]);
                    *(u32x4*)(out + off) = w; }
                asm volatile("" ::: "memory");
            }
        }
    }
};
struct EpiWin {
    static constexpr bool PERM = true;
    bf16_t *QKR, *UE; float* GATES; const float* bias;
    __device__ __forceinline__ void operator()(const f32x4 (&acc)[2][2][4][2], const Unit& u, int wr, int wc, int fr, int fq) const {
        const int c8 = wc * 32 + 8 * fq; const int pn = u.pn;
        if (pn == 8) {
            if (c8 < 16) {
                const f32x4 b0 = *(const f32x4*)(bias + 2048 + c8), b1 = *(const f32x4*)(bias + 2048 + c8 + 4);
#pragma unroll
                for (int ai = 0; ai < 2; ++ai)
#pragma unroll
                    for (int m = 0; m < 4; ++m) { float* gp = GATES + (size_t)(u.pm * BM + wr * 64 + fr + ai * HALF + m * 16) * 16 + c8;
                        *(f32x4*)gp = acc[ai][0][m][0] + b0; *(f32x4*)(gp + 4) = acc[ai][0][m][1] + b1; }
            }
            return;
        }
        bf16_t* base; size_t sa, sm1, sm2, sb;
        if (pn < 6) { bf16_t* buf = QKR + (size_t)(pn >> 1) * (32u << 20); base = buf + (size_t)(u.pm * BM + wr * 64 + fr) * 512 + (pn & 1) * BM + c8; sa = (size_t)HALF * 512; sm1 = 16 * 512; sm2 = 32 * 512; sb = HALF; }
        else { const int ch = (pn - 6) * BM + c8, gq = ch >> 4, hi0 = ch & 15; base = UE + ((size_t)gq * SNROW + u.pm * 8 + wr * 2) * UEXT + fr * 16 + hi0; sa = (size_t)4 * UEXT; sm1 = 256; sm2 = UEXT; sb = (size_t)8 * SNROW * UEXT; }
        const bool sig = (pn == 4 || pn == 5);
#pragma unroll
        for (int bj = 0; bj < 2; ++bj) {
            const f32x4 b0 = *(const f32x4*)(bias + pn * BM + bj * HALF + c8), b1 = *(const f32x4*)(bias + pn * BM + bj * HALF + c8 + 4);
#pragma unroll
            for (int ai = 0; ai < 2; ++ai)
#pragma unroll
                for (int m = 0; m < 4; ++m) { f32x4 v0 = acc[ai][bj][m][0] + b0, v1 = acc[ai][bj][m][1] + b1;
                    if (sig) {
#pragma unroll
                        for (int j = 0; j < 4; ++j) { v0[j] = sigmoidf_(v0[j]); v1[j] = sigmoidf_(v1[j]); } }
                    u32x4 w; w.x = cvt_pk_bf16(v0[0], v0[1]); w.y = cvt_pk_bf16(v0[2], v0[3]); w.z = cvt_pk_bf16(v1[0], v1[1]); w.w = cvt_pk_bf16(v1[2], v1[3]);
                    *(u32x4*)(base + ai * sa + (m & 1) * sm1 + (m >> 1) * sm2 + bj * sb) = w; }
        }
    }
};
struct EpiF32 {
    static constexpr bool PERM = false;
    float* C; int ldc;
    __device__ __forceinline__ void operator()(const f32x4 (&acc)[2][2][4][2], const Unit& u, int wr, int wc, int fr, int fq) const {
        const int row0 = u.pm * BM + wr * 64 + fr, col0 = u.pn * BM + wc * 32 + 4 * fq;
#pragma unroll
        for (int ai = 0; ai < 2; ++ai)
#pragma unroll
            for (int m = 0; m < 4; ++m) { float* rowp = C + (size_t)(row0 + ai * HALF + m * 16) * ldc + col0;
#pragma unroll
                for (int bj = 0; bj < 2; ++bj)
#pragma unroll
                    for (int n = 0; n < 2; ++n) *(f32x4*)(rowp + bj * HALF + n * 16) = acc[ai][bj][m][n]; }
    }
};
struct EpiS5Out {
    static constexpr bool PERM = true;
    bf16_t* Y;
    __device__ __forceinline__ void operator()(const f32x4 (&acc)[2][2][4][2], const Unit& u, int wr, int wc, int fr, int fq) const {
        const int row0 = u.pm * BM + wr * 64 + fr, c8 = u.pn * BM + wc * 32 + 8 * fq;
#pragma unroll
        for (int ai = 0; ai < 2; ++ai)
#pragma unroll
            for (int m = 0; m < 4; ++m) { const int row = row0 + ai * HALF + m * 16, gq = row / SNROW, r = row % SNROW;
#pragma unroll
                for (int bj = 0; bj < 2; ++bj) { const f32x4 v0 = acc[ai][bj][m][0], v1 = acc[ai][bj][m][1]; const int col = c8 + bj * HALF, t = col >> 4, ho0 = col & 15;
                    u32x4 w; w.x = cvt_pk_bf16(gelu_tanh(v0[0]), gelu_tanh(v0[1])); w.y = cvt_pk_bf16(gelu_tanh(v0[2]), gelu_tanh(v0[3]));
                    w.z = cvt_pk_bf16(gelu_tanh(v1[0]), gelu_tanh(v1[1])); w.w = cvt_pk_bf16(gelu_tanh(v1[2]), gelu_tanh(v1[3]));
                    *(u32x4*)(Y + ((size_t)r * SL + t) * 512 + gq * 16 + ho0) = w; } }
    }
};
struct EpiGlu {
    static constexpr bool PERM = true;
    const bf16_t* Y; bf16_t* Z; const float* bias;
    __device__ __forceinline__ void operator()(const f32x4 (&acc)[2][2][4][2], const Unit& u, int wr, int wc, int fr, int fq) const {
        const int row0 = u.pm * BM + wr * 64 + fr, c8 = u.pn * BM + wc * 32 + 8 * fq;
        f32x4 bv[2][2];
#pragma unroll
        for (int bj = 0; bj < 2; ++bj)
#pragma unroll
            for (int n = 0; n < 2; ++n) bv[bj][n] = *(const f32x4*)(bias + c8 + bj * HALF + 4 * n);
#pragma unroll
        for (int ai = 0; ai < 2; ++ai)
#pragma unroll
            for (int m = 0; m < 4; ++m) { const size_t off = (size_t)(row0 + ai * HALF + m * 16) * 512 + c8;
#pragma unroll
                for (int bj = 0; bj < 2; ++bj) { const f32x4 v0 = acc[ai][bj][m][0] + bv[bj][0], v1 = acc[ai][bj][m][1] + bv[bj][1];
                    const u32x4 y = *(const u32x4*)(Y + off + bj * HALF);
                    u32x4 w; w.x = cvt_pk_bf16(bflo(y.x) * sigmoidf_(v0[0]), bfhi(y.x) * sigmoidf_(v0[1])); w.y = cvt_pk_bf16(bflo(y.y) * sigmoidf_(v0[2]), bfhi(y.y) * sigmoidf_(v0[3]));
                    w.z = cvt_pk_bf16(bflo(y.z) * sigmoidf_(v1[0]), bfhi(y.z) * sigmoidf_(v1[1])); w.w = cvt_pk_bf16(bflo(y.w) * sigmoidf_(v1[2]), bfhi(y.w) * sigmoidf_(v1[3]));
                    *(u32x4*)(Z + off + bj * HALF) = w; } }
    }
};
}

struct Args { const float* in[31]; float* out; unsigned char* ws; int ph_lo, ph_hi; };

template <int MODE> __device__ __forceinline__ int dest_row(int n) {
    if (MODE == 1) { if (n < DFF) return (n >> 7) * 256 + (n & 127); n -= DFF; return (n >> 7) * 256 + 128 + (n & 127); }
    if (MODE == 2) { if (n < 1536) return n; if (n < 1552) return 2048 + (n - 1536); return n - 16; }
    return n;
}
template <int MODE> __device__ __forceinline__ void transpose_item(const float* W, int K, int N, bf16_t* WT, LAS float* scr, int item, int lane) {
    const int nblk = (N + 31) / 32, kb = item / nblk, nb = item % nblk, k0 = 64 * kb, n0 = 32 * nb;
    const int nn = n0 + (lane & 31);
    float wl[32];
#pragma unroll
    for (int i = 0; i < 32; ++i) { const int kk = 2 * i + (lane >> 5); wl[i] = (nn < N) ? W[(size_t)(k0 + kk) * N + nn] : 0.f; }
#pragma unroll
    for (int i = 0; i < 32; ++i) { const int kk = 2 * i + (lane >> 5); scr[kk * 33 + (lane & 31)] = wl[i]; }
    asm volatile("s_waitcnt lgkmcnt(0)" ::: "memory");
    const int c = lane & 7;
#pragma unroll
    for (int j = 0; j < 4; ++j) { const int nl = (lane >> 3) + 8 * j; const LAS float* s = scr + (8 * c) * 33 + nl;
        u32x4 o; o.x = cvt_pk_bf16(s[0 * 33], s[1 * 33]); o.y = cvt_pk_bf16(s[2 * 33], s[3 * 33]); o.z = cvt_pk_bf16(s[4 * 33], s[5 * 33]); o.w = cvt_pk_bf16(s[6 * 33], s[7 * 33]);
        if (n0 + nl < N) *(u32x4*)(WT + (size_t)dest_row<MODE>(n0 + nl) * K + k0 + 8 * c) = o; }
    asm volatile("s_waitcnt lgkmcnt(0)" ::: "memory");
}

__device__ __forceinline__ void phase0(const Args& a, LAS unsigned char* lds) {
    const int tid = threadIdx.x, lane = tid & 63, wave = tid >> 6, G = gridDim.x, blk = blockIdx.x;
    unsigned char* ws = a.ws;
    {
        LAS float* sc = (LAS float*)lds;
        const float* c = a.in[1];
        for (int i = tid; i < NB * DM; i += 512) sc[i] = siluf_(c[i]);
        __syncthreads();
        float* modp = (float*)(ws + WS_MODP);
        for (int idx = blk * 512 + tid; idx < MODW * 16; idx += G * 512) {
            const int j = idx % MODW, ks = idx / MODW;
            float acc[16];
#pragma unroll
            for (int b = 0; b < 16; ++b) acc[b] = 0.f;
            const float* w = a.in[2] + (size_t)(ks * 64) * MODW + j;
            const LAS float* scp = sc + ks * 64;
#pragma unroll 1
            for (int k0 = 0; k0 < 64; k0 += 16) { float wv[16];
#pragma unroll
                for (int k = 0; k < 16; ++k) wv[k] = w[(size_t)(k0 + k) * MODW];
#pragma unroll
                for (int k = 0; k < 16; ++k)
#pragma unroll
                    for (int b = 0; b < 16; ++b) acc[b] += scp[b * DM + k0 + k] * wv[k]; }
#pragma unroll
            for (int b = 0; b < 16; ++b) modp[(size_t)(ks * 16 + b) * MODW + j] = acc[b];
        }
        __syncthreads();
    }
    {
        LAS float* Er = (LAS float*)lds; LAS float* Ei = Er + 1024; LAS float* A1r = Ei + 1024; LAS float* A1i = A1r + 1024;
        LAS float* Cr = A1i + 1024; LAS float* Ci = Cr + 1024; LAS float* Br = Ci + 1024; LAS float* Bi = Br + 1024;
        const float *lam_re = a.in[13], *lam_im = a.in[14], *log_step = a.in[15], *b_re = a.in[16], *b_im = a.in[17], *c_re = a.in[18], *c_im = a.in[19];
        float* Ktab = (float*)(ws + WS_KTAB); bf16_t* Bt1 = (bf16_t*)(ws + WS_BT1); bf16_t* Bt2 = (bf16_t*)(ws + WS_BT2);
        for (int it = blk; it < 32 * 2 * (SL / 16); it += G) {
            const int g = it / (2 * (SL / 16)), d = (it / (SL / 16)) & 1, tq = it % (SL / 16);
            for (int e = tid; e < 1024; e += 512) {
                const int tl = e >> 6, p = e & 63, tau = tq * 16 + tl;
                const float lr = lam_re[(d * 32 + g) * 64 + p], li = lam_im[(d * 32 + g) * 64 + p], step = expf(log_step[d * 32 + g]);
                float ar, ai; cpow(lr, li, step, 1, ar, ai);
                const float nr = ar - 1.f, ni = ai, inv = 1.f / (lr * lr + li * li);
                const float cfr = (nr * lr + ni * li) * inv, cfi = (ni * lr - nr * li) * inv;
                float pr, pi; cpow(lr, li, step, tau, pr, pi);
                Er[e] = pr * cfr - pi * cfi; Ei[e] = pr * cfi + pi * cfr;
                float qr, qi; cpow(lr, li, step, tau + 1, qr, qi);
                A1r[e] = qr; A1i[e] = qi;
                Cr[e] = c_re[(size_t)((d * 32 + g) * 16) * 64 + e]; Ci[e] = c_im[(size_t)((d * 32 + g) * 16) * 64 + e];
                Br[e] = b_re[(size_t)g * 1024 + e]; Bi[e] = b_im[(size_t)g * 1024 + e];
            }
            __syncthreads();
            { const int hh = tid & 1, ho = (tid >> 1) & 15, tl = tid >> 5;
              f32x4 s0 = {0.f, 0.f, 0.f, 0.f}, s1 = {0.f, 0.f, 0.f, 0.f};
              for (int p = 0; p < 64; ++p) { const float cr = Cr[ho * 64 + p], ci = Ci[ho * 64 + p], er = Er[tl * 64 + p], ei = Ei[tl * 64 + p];
                  const float cer = cr * er - ci * ei, cei = cr * ei + ci * er;
                  const f32x4 br0 = *(const LAS f32x4*)(Br + p * 16 + hh * 8), br1 = *(const LAS f32x4*)(Br + p * 16 + hh * 8 + 4), bi0 = *(const LAS f32x4*)(Bi + p * 16 + hh * 8), bi1 = *(const LAS f32x4*)(Bi + p * 16 + hh * 8 + 4);
                  s0 += br0 * cer - bi0 * cei; s1 += br1 * cer - bi1 * cei; }
              float* kp = Ktab + (size_t)(((g * 2 + d) * SL) + tq * 16 + tl) * 256 + ho * 16 + hh * 8;
              *(f32x4*)kp = s0; *(f32x4*)(kp + 4) = s1; }
            for (int q = tid; q < 2048; q += 512) {
                const int nl = q & 127, tl = q >> 7, ri = nl >> 6, p = nl & 63, tau = tq * 16 + tl, s = d ? tau : SL - 1 - tau;
                const float er = Er[tl * 64 + p], ei = Ei[tl * 64 + p];
                unsigned w[8];
#pragma unroll
                for (int h2 = 0; h2 < 8; ++h2) { const float br0 = Br[p * 16 + 2 * h2], bi0 = Bi[p * 16 + 2 * h2], br1 = Br[p * 16 + 2 * h2 + 1], bi1 = Bi[p * 16 + 2 * h2 + 1];
                    const float v0 = ri ? (er * bi0 + ei * br0) : (er * br0 - ei * bi0), v1 = ri ? (er * bi1 + ei * br1) : (er * br1 - ei * bi1);
                    w[h2] = cvt_pk_bf16(v0, v1); }
                bf16_t* dst = Bt1 + ((size_t)g * 256 + d * 128 + nl) * UK + s * 16;
                *(u32x4*)dst = (u32x4){w[0], w[1], w[2], w[3]}; *(u32x4*)(dst + 8) = (u32x4){w[4], w[5], w[6], w[7]};
            }
            for (int q = tid; q < 4096; q += 512) {
                const int pg = q & 7, ri = (q >> 3) & 1, ho = (q >> 4) & 15, tl = q >> 8, tau = tq * 16 + tl, t = d ? SL - 1 - tau : tau;
                unsigned w[4];
#pragma unroll
                for (int j2 = 0; j2 < 4; ++j2) { float v[2];
#pragma unroll
                    for (int e2 = 0; e2 < 2; ++e2) { const int p = pg * 8 + j2 * 2 + e2; const float cr = Cr[ho * 64 + p], ci = Ci[ho * 64 + p], qr = A1r[tl * 64 + p], qi = A1i[tl * 64 + p];
                        v[e2] = ri ? -(cr * qi + ci * qr) : (cr * qr - ci * qi); }
                    w[j2] = cvt_pk_bf16(v[0], v[1]); }
                *(u32x4*)(Bt2 + ((size_t)g * UK + t * 16 + ho) * UEXT + UK + d * 128 + ri * 64 + pg * 8) = (u32x4){w[0], w[1], w[2], w[3]};
            }
            __syncthreads();
        }
    }
    {
        LAS float* scr = (LAS float*)(lds + wave * 16384);
        const int gw = blk * 8 + wave, NGW = G * 8;
        constexpr int I_UP = 16 * 176, I_DN = 44 * 32, I_IN = 16 * 65, I_OUT = 16 * 32, I_GLU = 8 * 16;
        constexpr int NITEMS = 2 * I_UP + 2 * I_DN + I_IN + I_OUT + I_GLU;
        for (int it = gw; it < NITEMS; it += NGW) {
            int r = it;
            if (r < I_UP) { transpose_item<1>(a.in[4], DM, NUP, (bf16_t*)(ws + WS_WUP1), scr, r, lane); continue; } r -= I_UP;
            if (r < I_UP) { transpose_item<1>(a.in[27], DM, NUP, (bf16_t*)(ws + WS_WUP2), scr, r, lane); continue; } r -= I_UP;
            if (r < I_DN) { transpose_item<0>(a.in[5], DFF, DM, (bf16_t*)(ws + WS_WDN1), scr, r, lane); continue; } r -= I_DN;
            if (r < I_DN) { transpose_item<0>(a.in[28], DFF, DM, (bf16_t*)(ws + WS_WDN2), scr, r, lane); continue; } r -= I_DN;
            if (r < I_IN) { transpose_item<2>(a.in[8], DM, NIN, (bf16_t*)(ws + WS_WIN), scr, r, lane); continue; } r -= I_IN;
            if (r < I_OUT) { transpose_item<0>(a.in[24], DM, DM, (bf16_t*)(ws + WS_WOUT), scr, r, lane); continue; } r -= I_OUT;
            transpose_item<0>(a.in[21], 512, 512, (bf16_t*)(ws + WS_WGLU), scr, r, lane);
        }
        const int gt = blk * 512 + tid, GT = G * 512;
        u32x4* padp = (u32x4*)((bf16_t*)(ws + WS_WIN) + (size_t)NIN * DM);
        for (int i = gt; i < (NINP - NIN) * DM / 8; i += GT) padp[i] = (u32x4){0u, 0u, 0u, 0u};
        float* binp = (float*)(ws + WS_BIN);
        for (int i = gt; i < NINP; i += GT) { if (i < NIN) binp[dest_row<2>(i)] = a.in[9][i]; else binp[i] = 0.f; }
    }
}

__device__ __forceinline__ void phase1(const Args& a, LAS unsigned char* lds) {
    const int tid = threadIdx.x, lane = tid & 63, wave = tid >> 6, G = gridDim.x;
    const int gt = blockIdx.x * 512 + tid, GT = G * 512;
    unsigned char* ws = a.ws;
    const float* modp = (const float*)(ws + WS_MODP); float* mod = (float*)(ws + WS_MOD); const float* b_ada = a.in[3];
    LAS float* lsh = (LAS float*)lds;
    bf16_t* xm = (bf16_t*)(ws + WS_XM); const float* x = a.in[0];
    for (int rb = blockIdx.x; rb < MTOK / 256; rb += G) {
        const int b = rb >> 4;
        __syncthreads();
        for (int i = tid; i < 2048; i += 512) { float s = b_ada[i];
#pragma unroll
            for (int ks = 0; ks < 16; ++ks) s += modp[(size_t)(ks * 16 + b) * MODW + i];
            lsh[i] = (i >= 1024) ? s + 1.0f : s; }
        __syncthreads();
        f32x4 s0[4], s1[4];
#pragma unroll
        for (int j = 0; j < 4; ++j) { s0[j] = *((const LAS f32x4*)lsh + lane + 64 * j); s1[j] = *((const LAS f32x4*)(lsh + 1024) + lane + 64 * j); }
        for (int it = 0; it < 8; ++it) { const int row0 = rb * 256 + it * 32 + wave * 4;
            f32x4 v[4][4];
#pragma unroll
            for (int r = 0; r < 4; ++r)
#pragma unroll
                for (int j = 0; j < 4; ++j) v[r][j] = __builtin_nontemporal_load((const f32x4*)(x + (size_t)(row0 + r) * DM) + lane + 64 * j);
#pragma unroll
            for (int r = 0; r < 4; ++r)
#pragma unroll
                for (int j = 0; j < 4; ++j) { const f32x4 o = v[r][j] * s1[j] + s0[j]; u32x2 w; w.x = cvt_pk_bf16(o[0], o[1]); w.y = cvt_pk_bf16(o[2], o[3]); *((u32x2*)(xm + (size_t)(row0 + r) * DM) + lane + 64 * j) = w; } }
    }
    for (int i = gt; i < NB * MODW; i += GT) { const int b = i / MODW, j = i % MODW; float s = b_ada[j];
#pragma unroll
        for (int ks = 0; ks < 16; ++ks) s += modp[(size_t)(ks * 16 + b) * MODW + j];
        mod[i] = s; }
}
__device__ __forceinline__ void tbuild(const Args& a, int vb, int nvb) {
    const int gt = vb * 512 + threadIdx.x, GT = nvb * 512;
    unsigned char* ws = a.ws;
    const float* Ktab = (const float*)(ws + WS_KTAB); bf16_t* Bt2 = (bf16_t*)(ws + WS_BT2); const float* dsk = a.in[20];
    constexpr int TB_N = 32 * UK * (UK / 8);
    for (int i0 = gt; i0 < TB_N; i0 += 4 * GT) {
        f32x4 v0[4], v1[4];
#pragma unroll
        for (int u = 0; u < 4; ++u) { const int i = i0 + u * GT; if (i < TB_N) {
            const int kg = i % (UK / 8), n = (i / (UK / 8)) % UK, g = i / ((UK / 8) * UK), t = n >> 4, ho = n & 15, s = kg >> 1, hi0 = (kg & 1) * 8;
            const int dsel = (s > t) ? 1 : 0, lag = (s < t) ? (t - s) : (s - t);
            const float* p = Ktab + (size_t)((g * 2 + dsel) * SL + lag) * 256 + ho * 16 + hi0; v0[u] = *(const f32x4*)p; v1[u] = *(const f32x4*)(p + 4);
            if (s == t) { const float* q = Ktab + (size_t)((g * 2 + 1) * SL) * 256 + ho * 16 + hi0; v0[u] += *(const f32x4*)q; v1[u] += *(const f32x4*)(q + 4);
                const float dd = dsk[g * 16 + ho];
#pragma unroll
                for (int j = 0; j < 4; ++j) { v0[u][j] += (hi0 + j == ho) ? dd : 0.f; v1[u][j] += (hi0 + 4 + j == ho) ? dd : 0.f; } } } }
#pragma unroll
        for (int u = 0; u < 4; ++u) { const int i = i0 + u * GT; if (i < TB_N) {
            const int kg = i % (UK / 8), n = (i / (UK / 8)) % UK, g = i / ((UK / 8) * UK);
            u32x4 w; w.x = cvt_pk_bf16(v0[u][0], v0[u][1]); w.y = cvt_pk_bf16(v0[u][2], v0[u][3]); w.z = cvt_pk_bf16(v1[u][0], v1[u][1]); w.w = cvt_pk_bf16(v1[u][2], v1[u][3]);
            *(u32x4*)(Bt2 + ((size_t)g * UK + n) * UEXT + kg * 8) = w; } }
    }
}

__device__ __forceinline__ void mod_pass(const float* src, const float* mod, int sub, bf16_t* xm) {
    const int lane = threadIdx.x & 63, gw = blockIdx.x * 8 + (threadIdx.x >> 6), NGW = gridDim.x * 8;
    for (int row0 = gw * 4; row0 < MTOK; row0 += NGW * 4) {
        const int b = row0 >> 12;
        f32x4 v[4][4];
#pragma unroll
        for (int r = 0; r < 4; ++r)
#pragma unroll
            for (int j = 0; j < 4; ++j) v[r][j] = *((const f32x4*)(src + (size_t)(row0 + r) * DM) + lane + 64 * j);
        const f32x4* sh = (const f32x4*)(mod + (size_t)b * MODW + sub * 3072) + lane; const f32x4* scl = (const f32x4*)(mod + (size_t)b * MODW + sub * 3072 + 1024) + lane;
#pragma unroll
        for (int j = 0; j < 4; ++j) { const f32x4 s1 = scl[64 * j] + 1.0f, s0 = sh[64 * j];
#pragma unroll
            for (int r = 0; r < 4; ++r) { const f32x4 o = v[r][j] * s1 + s0; u32x2 w; w.x = cvt_pk_bf16(o[0], o[1]); w.y = cvt_pk_bf16(o[2], o[3]); *((u32x2*)(xm + (size_t)(row0 + r) * DM) + lane + 64 * j) = w; } }
    }
}

template <bool FINAL>
__device__ __forceinline__ void row_pass_b(const bf16_t* src, f32x2n* stats, const float* lng, const float* lnb, const float* mod, int sub, bf16_t* xm, float* outf) {
    const int lane = threadIdx.x & 63, gw = blockIdx.x * 8 + (threadIdx.x >> 6), NGW = gridDim.x * 8;
    f32x4 gg[4], bb[4];
#pragma unroll
    for (int j = 0; j < 2; ++j) { gg[2 * j] = *(const f32x4*)(lng + lane * 8 + 512 * j); gg[2 * j + 1] = *(const f32x4*)(lng + lane * 8 + 512 * j + 4);
        bb[2 * j] = *(const f32x4*)(lnb + lane * 8 + 512 * j); bb[2 * j + 1] = *(const f32x4*)(lnb + lane * 8 + 512 * j + 4); }
    for (int row0 = gw * 4; row0 < MTOK; row0 += NGW * 4) {
        const int b = row0 >> 12;
        u32x4 raw[4][2];
#pragma unroll
        for (int r = 0; r < 4; ++r)
#pragma unroll
            for (int j = 0; j < 2; ++j) raw[r][j] = FINAL ? __builtin_nontemporal_load((const u32x4*)(src + (size_t)(row0 + r) * DM + lane * 8 + 512 * j)) : *(const u32x4*)(src + (size_t)(row0 + r) * DM + lane * 8 + 512 * j);
#pragma unroll
        for (int r = 0; r < 4; ++r) { const int row = row0 + r;
            f32x4 v[4];
#pragma unroll
            for (int j = 0; j < 2; ++j) { const u32x4 y = raw[r][j];
                v[2 * j] = (f32x4){bflo(y.x), bfhi(y.x), bflo(y.y), bfhi(y.y)}; v[2 * j + 1] = (f32x4){bflo(y.z), bfhi(y.z), bflo(y.w), bfhi(y.w)}; }
            float s = 0.f;
#pragma unroll
            for (int j = 0; j < 4; ++j) s += (v[j][0] + v[j][1]) + (v[j][2] + v[j][3]);
            const float mean = wave_sum(s) * (1.f / DM); float s2 = 0.f;
#pragma unroll
            for (int j = 0; j < 4; ++j) { const f32x4 d = v[j] - mean; s2 += (d[0] * d[0] + d[1] * d[1]) + (d[2] * d[2] + d[3] * d[3]); }
            const float rstd = 1.f / sqrtf(wave_sum(s2) * (1.f / DM) + LN_EPS);
#pragma unroll
            for (int j = 0; j < 4; ++j) v[j] = (v[j] - mean) * rstd * gg[j] + bb[j];
            if (FINAL) {
#pragma unroll
                for (int j = 0; j < 2; ++j) { float* o = outf + (size_t)row * DM + lane * 8 + 512 * j; *(f32x4*)o = v[2 * j]; *(f32x4*)(o + 4) = v[2 * j + 1]; }
            } else {
                if (lane == 0) stats[row] = (f32x2n){mean, rstd};
                const float* sh = mod + (size_t)b * MODW + sub * 3072 + lane * 8; const float* scl = sh + 1024;
#pragma unroll
                for (int j = 0; j < 2; ++j) { const f32x4 o0 = v[2 * j] * (*(const f32x4*)(scl + 512 * j) + 1.0f) + *(const f32x4*)(sh + 512 * j), o1 = v[2 * j + 1] * (*(const f32x4*)(scl + 512 * j + 4) + 1.0f) + *(const f32x4*)(sh + 512 * j + 4);
                    u32x4 w; w.x = cvt_pk_bf16(o0[0], o0[1]); w.y = cvt_pk_bf16(o0[2], o0[3]); w.z = cvt_pk_bf16(o1[0], o1[1]); w.w = cvt_pk_bf16(o1[2], o1[3]);
                    *(u32x4*)(xm + (size_t)row * DM + lane * 8 + 512 * j) = w; }
            }
        }
    }
}

__device__ __forceinline__ void phase_conv(const Args& a) {
    const int gt = blockIdx.x * 512 + threadIdx.x, GT = gridDim.x * 512;
    const bf16_t* qkr = (const bf16_t*)(a.ws + WS_QKR); bf16_t* qkc = (bf16_t*)(a.ws + WS_QKC); const float* cw = a.in[10]; const float* cb = a.in[11];
    for (int i = gt; i < (MTOK / 4) * 64; i += GT) {
        const int cg8 = i & 63, tok0 = (i >> 6) * 4, pos0 = tok0 & (SEQ - 1), c0 = cg8 * 8;
        u32x4 x[8];
#pragma unroll
        for (int r = 0; r < 8; ++r) { const int pp = pos0 + r - 2; x[r] = (pp >= 0 && pp < SEQ) ? *(const u32x4*)(qkr + (size_t)(tok0 + r - 2) * 512 + c0) : (u32x4){0u, 0u, 0u, 0u}; }
        f32x4 w0[5], w1[5];
#pragma unroll
        for (int jj = 0; jj < 5; ++jj) { w0[jj] = *(const f32x4*)(cw + jj * 512 + c0); w1[jj] = *(const f32x4*)(cw + jj * 512 + c0 + 4); }
        const f32x4 b0 = *(const f32x4*)(cb + c0), b1 = *(const f32x4*)(cb + c0 + 4);
        const float sc = (c0 >= 256) ? 0.125f : 1.0f;
#pragma unroll
        for (int t = 0; t < 4; ++t) {
            f32x4 a0 = b0, a1 = b1;
#pragma unroll
            for (int jj = 0; jj < 5; ++jj) { const u32x4 xv = x[t + jj];
                a0 += (f32x4){bflo(xv.x), bfhi(xv.x), bflo(xv.y), bfhi(xv.y)} * w0[jj]; a1 += (f32x4){bflo(xv.z), bfhi(xv.z), bflo(xv.w), bfhi(xv.w)} * w1[jj]; }
            u32x4 w; w.x = cvt_pk_bf16(siluf_(a0[0]) * sc, siluf_(a0[1]) * sc); w.y = cvt_pk_bf16(siluf_(a0[2]) * sc, siluf_(a0[3]) * sc);
            w.z = cvt_pk_bf16(siluf_(a1[0]) * sc, siluf_(a1[1]) * sc); w.w = cvt_pk_bf16(siluf_(a1[2]) * sc, siluf_(a1[3]) * sc);
            *(u32x4*)(qkc + (size_t)(tok0 + t) * 512 + c0) = w;
        }
    }
}

namespace ml {
constexpr int QS = 0, KS = 18432, VT = 36864, PS = 80384, CT = 115200, SM = 138240;
constexpr int QSTR = 72, KSTR = 72, VSTR = 136, PSTR = 136, CSTR = 72, KWSTR = 136;
template <int KS>
__device__ __forceinline__ f32x16 mma_tile_t(f32x16 acc, const LAS bf16_t* A, int lda, const LAS bf16_t* B, int ldb, int lane) {
    const LAS bf16_t* ap = A + (lane & 31) * lda + (lane >> 5) * 8; const LAS bf16_t* bp = B + (lane & 31) * ldb + (lane >> 5) * 8;
#pragma unroll
    for (int k0 = 0; k0 < KS; k0 += 4) {
        bf16x8 av[4], bv[4];
#pragma unroll
        for (int k = 0; k < 4; ++k) if (k0 + k < KS) { av[k] = *(const LAS bf16x8*)(ap + (k0 + k) * 16); bv[k] = *(const LAS bf16x8*)(bp + (k0 + k) * 16); }
#pragma unroll
        for (int k = 0; k < 4; ++k) if (k0 + k < KS) acc = __builtin_amdgcn_mfma_f32_32x32x16_bf16(av[k], bv[k], acc, 0, 0, 0);
    }
    return acc;
}
__device__ __forceinline__ f32x16 mma_tile(f32x16 acc, const LAS bf16_t* A, int lda, const LAS bf16_t* B, int ldb, int ksteps, int lane) {
    switch (ksteps) {
    case 2: return mma_tile_t<2>(acc, A, lda, B, ldb, lane);
    case 4: return mma_tile_t<4>(acc, A, lda, B, ldb, lane);
    case 6: return mma_tile_t<6>(acc, A, lda, B, ldb, lane);
    default: return mma_tile_t<8>(acc, A, lda, B, ldb, lane);
    }
}
__device__ __forceinline__ float gate_scan(const LAS float* gis, const LAS float* lfs, LAS float* aS, float m_mem, int lane) {
    LAS float* Mt = aS + 128; LAS float* wint = Mt + 128; LAS float* emt = wint + 128; LAS float* wst = emt + 128; LAS float* eM = wst + 128; LAS float* scal = eM + 128;
    const float l0 = lfs[2 * lane], l1 = lfs[2 * lane + 1]; const float ps = l0 + l1; float incl = ps;
#pragma unroll
    for (int o = 1; o < 64; o <<= 1) { const float t = __shfl_up(incl, o); if (lane >= o) incl += t; }
    const float excl = incl - ps, b0 = excl + l0, b1 = excl + ps;
    const float a0 = gis[2 * lane] - b0, a1 = gis[2 * lane + 1] - b1;
    float inclm = fmaxf(a0, a1);
#pragma unroll
    for (int o = 1; o < 64; o <<= 1) { const float t = __shfl_up(inclm, o); if (lane >= o) inclm = fmaxf(inclm, t); }
    float exclm = __shfl_up(inclm, 1); if (lane == 0) exclm = -3.0e38f;
    const float pm0 = fmaxf(exclm, a0), pm1 = fmaxf(pm0, a1);
    const float M0 = fmaxf(m_mem, pm0), M1 = fmaxf(m_mem, pm1);
    aS[2 * lane] = a0; aS[2 * lane + 1] = a1; Mt[2 * lane] = M0; Mt[2 * lane + 1] = M1;
    wint[2 * lane] = __expf(m_mem - M0); wint[2 * lane + 1] = __expf(m_mem - M1);
    emt[2 * lane] = __expf(-(b0 + M0)); emt[2 * lane + 1] = __expf(-(b1 + M1));
    const float Mlast = __shfl(M1, 63), bend = __shfl(b1, 63);
    wst[2 * lane] = __expf(a0 - Mlast); wst[2 * lane + 1] = __expf(a1 - Mlast);
    eM[2 * lane] = __expf(fminf(Mlast - M0, 80.f)); eM[2 * lane + 1] = __expf(fminf(Mlast - M1, 80.f));
    if (lane == 0) scal[0] = __expf(m_mem - Mlast);
    return bend + Mlast;
}
constexpr int SCB = 3136;
__device__ __forceinline__ void run(const bf16_t* qkc, const bf16_t* vbuf, const float* gates, bf16_t* hout, int b, int h, int dir, LAS unsigned char* lds) {
    const int tid = threadIdx.x, lane = tid & 63, w = __builtin_amdgcn_readfirstlane(tid >> 6);
#define ML_PTRS(L, cb) LAS bf16_t* Qs = (LAS bf16_t*)((L) + QS); LAS bf16_t* Ks = (LAS bf16_t*)((L) + KS); LAS bf16_t* Vt = (LAS bf16_t*)((L) + VT); \
    LAS bf16_t* Ps = (LAS bf16_t*)((L) + PS); LAS bf16_t* Ct = (LAS bf16_t*)((L) + CT); \
    LAS float* aS = (LAS float*)((L) + SM + (cb) * SCB); LAS float* Mt = aS + 128; LAS float* wint = Mt + 128; LAS float* emt = wint + 128; LAS float* wst = emt + 128; LAS float* eMt = wst + 128; LAS float* scal = eMt + 128; (void)eMt; \
    LAS float* aSn = (LAS float*)((L) + SM + (1 - (cb)) * SCB); \
    LAS float* den = (LAS float*)((L) + SM + 2 * SCB); LAS float* gis = den + 128; LAS float* lfs = gis + 128; LAS float* den1 = lfs + 128; LAS float* qn = den1 + 128; (void)den1; (void)qn; \
    (void)Qs; (void)Ks; (void)Vt; (void)Ps; (void)Ct; (void)aS; (void)Mt; (void)wint; (void)emt; (void)den; (void)wst; (void)gis; (void)lfs; (void)scal; (void)aSn
    for (int i = tid; i < 160 * CSTR / 2; i += 512) ((LAS unsigned*)(lds + CT))[i] = 0u;
    for (int i = tid; i < 32 * VSTR / 2; i += 512) ((LAS unsigned*)(lds + VT + 128 * VSTR * 2))[i] = (i < VSTR / 2) ? 0x3F803F80u : 0u;
    f32x16 accC0;
#pragma unroll
    for (int i = 0; i < 16; ++i) accC0[i] = 0.f;
    float nst = 0.f;
    float m_mem = 0.f;
    const int tokbase = b * SEQ; const int sgn = dir ? -1 : 1;
    u32x4 qreg[2], kreg[2], vreg[4]; float gi_r = 0.f, gf_r = 0.f;
#define ML_BAR() do { asm volatile("s_waitcnt lgkmcnt(0)" ::: "memory"); __builtin_amdgcn_s_barrier(); asm volatile("" ::: "memory"); } while (0)
#define ML_POS(cc, r) (((dir) ? ((31 - (cc)) * 128 + 127) : ((cc) * 128)) + sgn * (r))
#define ML_LOAD(cc) do { \
    _Pragma("unroll") for (int i = 0; i < 2; ++i) { const int pc = tid + 512 * i, r = pc >> 3, c = pc & 7; qreg[i] = *(const u32x4*)(qkc + (size_t)(tokbase + ML_POS(cc, r)) * 512 + h * 64 + c * 8); } \
    _Pragma("unroll") for (int i = 0; i < 2; ++i) { const int r = tid & 127, c = (tid >> 7) + 4 * i; kreg[i] = *(const u32x4*)(qkc + (size_t)(tokbase + ML_POS(cc, r)) * 512 + 256 + h * 64 + c * 8); } \
    _Pragma("unroll") for (int i = 0; i < 4; ++i) { const int r = tid & 127, c = (tid >> 7) + 4 * i; vreg[i] = *(const u32x4*)(vbuf + (size_t)(tokbase + ML_POS(cc, r)) * 512 + h * 128 + c * 8); } } while (0)
#define ML_LOADG(cc) do { if (tid < 128) { const float* gp = gates + (size_t)(tokbase + ML_POS(cc, tid)) * 16 + dir * 4 + h; gi_r = gp[0]; gf_r = gp[8]; } } while (0)
#define ML_PUTG() do { if (tid < 128) { gis[tid] = gi_r; lfs[tid] = fminf(gf_r, 0.f) - __logf(1.0f + __expf(-fabsf(gf_r))); } } while (0)
    { ML_PTRS(lds, 0);
      ML_LOADG(0); ML_LOAD(0);
      ML_PUTG();
      __syncthreads();
      if (w == 1) m_mem = gate_scan(gis, lfs, aS, m_mem, lane);
      ML_LOADG(1);
      __syncthreads(); }
    for (int cc = 0; cc < 32; ++cc) {
        unsigned zo = 0u; asm volatile("" : "+s"(zo));
        LAS unsigned char* L = lds + zo;
        const int cb = cc & 1;
        ML_PTRS(L, cb);
#pragma unroll
        for (int i = 0; i < 2; ++i) { const int pc = tid + 512 * i, r = pc >> 3, c = pc & 7; *(LAS u32x4*)(Qs + r * QSTR + c * 8) = qreg[i]; }
#pragma unroll
        for (int i = 0; i < 2; ++i) { const int r = tid & 127, c = (tid >> 7) + 4 * i; *(LAS u32x4*)(Ks + r * KSTR + c * 8) = kreg[i]; }
#pragma unroll
        for (int i = 0; i < 4; ++i) { const int r = tid & 127, c = (tid >> 7) + 4 * i; const u32x4 x = vreg[i]; LAS bf16_t* vp = Vt + (c * 8) * VSTR + r;
            vp[0 * VSTR] = (bf16_t)(x.x & 0xffffu); vp[1 * VSTR] = (bf16_t)(x.x >> 16); vp[2 * VSTR] = (bf16_t)(x.y & 0xffffu); vp[3 * VSTR] = (bf16_t)(x.y >> 16);
            vp[4 * VSTR] = (bf16_t)(x.z & 0xffffu); vp[5 * VSTR] = (bf16_t)(x.z >> 16); vp[6 * VSTR] = (bf16_t)(x.w & 0xffffu); vp[7 * VSTR] = (bf16_t)(x.w >> 16); }
        ML_PUTG();
        ML_BAR();
        const int rb = w >> 1, par = w & 1;
        if (w == 1) { if (cc + 1 < 32) m_mem = gate_scan(gis, lfs, aSn, m_mem, lane); }
        else if (w == 3) {
#pragma unroll 1
            for (int rq = 0; rq < 4; ++rq) { f32x16 aq;
#pragma unroll
                for (int i = 0; i < 16; ++i) aq[i] = 0.f;
                aq = mma_tile(aq, Ct + 128 * CSTR, CSTR, Qs + rq * 32 * QSTR, QSTR, 4, lane);
                if (lane < 32) qn[rq * 32 + lane] = aq[0]; }
        }
        else {
        float psum = 0.f;
#pragma unroll 1
        for (int j = 0; j < 2; ++j) { const int st = par * 2 + j;
            if (st <= rb) {
                f32x16 acc;
#pragma unroll
                for (int i = 0; i < 16; ++i) acc[i] = 0.f;
                acc = mma_tile(acc, Ks + st * 32 * KSTR, KSTR, Qs + rb * 32 * QSTR, QSTR, 4, lane);
                const int t = rb * 32 + (lane & 31); const float em = eMt[t];
#pragma unroll
                for (int g4 = 0; g4 < 4; ++g4) { const int s0 = st * 32 + 8 * g4 + 4 * (lane >> 5);
                    const f32x4 ws4 = *(const LAS f32x4*)(wst + s0);
                    float v4[4];
#pragma unroll
                    for (int j = 0; j < 4; ++j) v4[j] = (s0 + j <= t) ? acc[4 * g4 + j] * (ws4[j] * em) : 0.f;
                    psum += (v4[0] + v4[1]) + (v4[2] + v4[3]);
                    u32x2 w; w.x = cvt_pk_bf16(v4[0], v4[1]); w.y = cvt_pk_bf16(v4[2], v4[3]);
                    *(LAS u32x2*)(Ps + t * PSTR + s0) = w; }
            } }
        psum += __shfl_xor(psum, 32);
        if (lane < 32) { if (par == 0) den[rb * 32 + lane] = psum; else if (rb >= 2) den1[rb * 32 + lane] = psum; }
        }
        ML_BAR();
        { const int r = tid & 127; const float ws_ = wst[r];
#pragma unroll
          for (int i = 0; i < 2; ++i) { const int c = (tid >> 7) + 4 * i; const u32x4 x = kreg[i]; LAS bf16_t* kp = Ks + (c * 8) * KWSTR + r;
            kp[0 * KWSTR] = f2bf(bflo(x.x) * ws_); kp[1 * KWSTR] = f2bf(bfhi(x.x) * ws_); kp[2 * KWSTR] = f2bf(bflo(x.y) * ws_); kp[3 * KWSTR] = f2bf(bfhi(x.y) * ws_);
            kp[4 * KWSTR] = f2bf(bflo(x.z) * ws_); kp[5 * KWSTR] = f2bf(bfhi(x.z) * ws_); kp[6 * KWSTR] = f2bf(bflo(x.w) * ws_); kp[7 * KWSTR] = f2bf(bfhi(x.w) * ws_); } }
        if (cc + 1 < 32) ML_LOAD(cc + 1);
        if (cc + 2 < 32) ML_LOADG(cc + 2);
#pragma unroll 1
        for (int j = 0; j < 2; ++j) { const int vt = w & 3, rb2 = (w < 4) ? (j ? 0 : 3) : (j ? 1 : 2);
            f32x16 accn;
#pragma unroll
            for (int i = 0; i < 16; ++i) accn[i] = 0.f;
            accn = mma_tile(accn, Ct + vt * 32 * CSTR, CSTR, Qs + rb2 * 32 * QSTR, QSTR, 4, lane);
            const int t = rb2 * 32 + (lane & 31); const float wi = wint[t];
#pragma unroll
            for (int i = 0; i < 16; ++i) accn[i] *= wi;
            accn = mma_tile(accn, Vt + vt * 32 * VSTR, VSTR, Ps + rb2 * 32 * PSTR, PSTR, (rb2 + 1) * 2, lane);
            const float dsum = den[t] + ((rb2 >= 2) ? den1[t] : 0.f) + wi * qn[t];
            const float rd = __builtin_amdgcn_rcpf(fmaxf(fabsf(dsum), emt[t]));
            bf16_t* ob = hout + (size_t)(tokbase + ML_POS(cc, t)) * 512 + h * 128 + vt * 32 + 4 * (lane >> 5);
#pragma unroll
            for (int g4 = 0; g4 < 4; ++g4) { u32x2 w; w.x = cvt_pk_bf16(accn[4 * g4] * rd, accn[4 * g4 + 1] * rd); w.y = cvt_pk_bf16(accn[4 * g4 + 2] * rd, accn[4 * g4 + 3] * rd);
                *(u32x2*)(ob + 8 * g4) = w; } }
        ML_BAR();
        { const float decay = scal[0];
          { const int vt = w >> 1, dt = w & 1;
#pragma unroll
            for (int i = 0; i < 16; ++i) accC0[i] *= decay;
            accC0 = mma_tile(accC0, Ks + dt * 32 * KWSTR, KWSTR, Vt + vt * 32 * VSTR, VSTR, 8, lane);
            const int v = vt * 32 + (lane & 31);
#pragma unroll
            for (int g4 = 0; g4 < 4; ++g4) { u32x2 w; w.x = cvt_pk_bf16(accC0[4 * g4], accC0[4 * g4 + 1]); w.y = cvt_pk_bf16(accC0[4 * g4 + 2], accC0[4 * g4 + 3]);
                *(LAS u32x2*)(Ct + v * CSTR + dt * 32 + 8 * g4 + 4 * (lane >> 5)) = w; } }
          { const int d = tid >> 3, sl = tid & 7; const LAS bf16_t* kr = Ks + d * KWSTR + sl * 16;
            const u32x4 x = *(const LAS u32x4*)kr, y = *(const LAS u32x4*)(kr + 8);
            float sacc = ((bflo(x.x) + bfhi(x.x)) + (bflo(x.y) + bfhi(x.y))) + ((bflo(x.z) + bfhi(x.z)) + (bflo(x.w) + bfhi(x.w)))
                       + ((bflo(y.x) + bfhi(y.x)) + (bflo(y.y) + bfhi(y.y))) + ((bflo(y.z) + bfhi(y.z)) + (bflo(y.w) + bfhi(y.w)));
            sacc += __shfl_xor(sacc, 1); sacc += __shfl_xor(sacc, 2); sacc += __shfl_xor(sacc, 4);
            nst = nst * decay + sacc; if (sl == 0) Ct[128 * CSTR + d] = f2bf(nst); } }
        ML_BAR();
    }
#undef ML_LOAD
#undef ML_LOADG
#undef ML_PUTG
#undef ML_POS
#undef ML_BAR
#undef ML_PTRS
}
}

__device__ __forceinline__ void s5_scan(const Args& a, int vblk, int nvblk) {
    const float *lam_re = a.in[13], *lam_im = a.in[14], *log_step = a.in[15];
    const float* Sloc = (const float*)(a.ws + WS_SLOC); bf16_t* Ue = (bf16_t*)(a.ws + WS_UEXT);
    for (int gi = vblk * 512 + threadIdx.x; gi < 65536; gi += nvblk * 512) {
        const int p = gi & 63, d = (gi >> 6) & 1, b = (gi >> 7) & 15, g = gi >> 11;
        const float lr = lam_re[(d * 32 + g) * 64 + p], li = lam_im[(d * 32 + g) * 64 + p], step = expf(log_step[d * 32 + g]);
        float ar, ai; cpow(lr, li, step, SL, ar, ai);
        float hr = 0.f, hi = 0.f;
        const float* sl = Sloc + (size_t)(g * SNROW + b * SNCH) * 256 + d * 128 + p;
        bf16_t* ue = Ue + (size_t)(g * SNROW + b * SNCH) * UEXT + UK + d * 128 + p;
        for (int c0 = 0; c0 < SNCH; c0 += 16) {
            float xr[16], xi[16];
#pragma unroll
            for (int u = 0; u < 16; ++u) { const int c = d ? SNCH - 1 - (c0 + u) : c0 + u; xr[u] = __builtin_nontemporal_load(sl + (size_t)c * 256); xi[u] = __builtin_nontemporal_load(sl + (size_t)c * 256 + 64); }
#pragma unroll
            for (int u = 0; u < 16; ++u) { const int c = d ? SNCH - 1 - (c0 + u) : c0 + u; ue[(size_t)c * UEXT] = f2bf(hr); ue[(size_t)c * UEXT + 64] = f2bf(hi);
                const float nr = ar * hr - ai * hi + xr[u], ni = ar * hi + ai * hr + xi[u]; hr = nr; hi = ni; }
        }
    }
}

template <int PART>
__device__ __forceinline__ void phase_mixfin(const Args& a, int vb, int nvb) {
    const int lane = threadIdx.x & 63, gw = vb * 8 + (threadIdx.x >> 6), NGW = nvb * 8;
    const bf16_t* hf = (const bf16_t*)(a.ws + WS_HF); const bf16_t* hb = (const bf16_t*)(a.ws + WS_HB); const bf16_t* og = (const bf16_t*)(a.ws + WS_OG);
    const bf16_t* z = (const bf16_t*)(a.ws + WS_Z); bf16_t* mixed = (bf16_t*)(a.ws + WS_XM);
    const float* ng = a.in[12]; const float* sg = a.in[23];
    for (int row0 = gw * 4; row0 < MTOK; row0 += NGW * 4) {
      u32x4 rf[4], rb_[4], rg[4], rz[4];
#pragma unroll
      for (int r = 0; r < 4; ++r) { const size_t o = (size_t)(row0 + r) * 512 + lane * 8;
          if (PART == 0) { rf[r] = __builtin_nontemporal_load((const u32x4*)(hf + o)); rb_[r] = __builtin_nontemporal_load((const u32x4*)(hb + o)); rg[r] = __builtin_nontemporal_load((const u32x4*)(og + o)); } else rz[r] = __builtin_nontemporal_load((const u32x4*)(z + o)); }
#pragma unroll
      for (int r = 0; r < 4; ++r) { const int row = row0 + r;
        if (PART == 0) {
            const u32x4 f = rf[r], bk = rb_[r], gt = rg[r];
            float v[8];
            v[0] = bflo(gt.x) * (bflo(f.x) + bflo(bk.x)); v[1] = bfhi(gt.x) * (bfhi(f.x) + bfhi(bk.x)); v[2] = bflo(gt.y) * (bflo(f.y) + bflo(bk.y)); v[3] = bfhi(gt.y) * (bfhi(f.y) + bfhi(bk.y));
            v[4] = bflo(gt.z) * (bflo(f.z) + bflo(bk.z)); v[5] = bfhi(gt.z) * (bfhi(f.z) + bfhi(bk.z)); v[6] = bflo(gt.w) * (bflo(f.w) + bflo(bk.w)); v[7] = bfhi(gt.w) * (bfhi(f.w) + bfhi(bk.w));
            float s = 0.f;
#pragma unroll
            for (int j = 0; j < 8; ++j) s += v[j];
#pragma unroll
            for (int of = 1; of < 16; of <<= 1) s += __shfl_xor(s, of);
            const float mu = s * (1.f / 128.f); float s2 = 0.f;
#pragma unroll
            for (int j = 0; j < 8; ++j) { v[j] -= mu; s2 += v[j] * v[j]; }
#pragma unroll
            for (int of = 1; of < 16; of <<= 1) s2 += __shfl_xor(s2, of);
            const float rstd = 1.f / sqrtf(s2 * (1.f / 128.f) + LN_EPS);
            const f32x4 g0 = *(const f32x4*)(ng + lane * 8), g1 = *(const f32x4*)(ng + lane * 8 + 4);
            u32x4 wv; wv.x = cvt_pk_bf16(v[0] * rstd * g0[0], v[1] * rstd * g0[1]); wv.y = cvt_pk_bf16(v[2] * rstd * g0[2], v[3] * rstd * g0[3]);
            wv.z = cvt_pk_bf16(v[4] * rstd * g1[0], v[5] * rstd * g1[1]); wv.w = cvt_pk_bf16(v[6] * rstd * g1[2], v[7] * rstd * g1[3]);
            *(u32x4*)(mixed + (size_t)row * DM + lane * 8) = wv;
        } else {
            const u32x4 zz = rz[r];
            float y[8];
            y[0] = bflo(zz.x); y[1] = bfhi(zz.x); y[2] = bflo(zz.y); y[3] = bfhi(zz.y); y[4] = bflo(zz.z); y[5] = bfhi(zz.z); y[6] = bflo(zz.w); y[7] = bfhi(zz.w);
            float q = 0.f;
#pragma unroll
            for (int j = 0; j < 8; ++j) q += y[j] * y[j];
            q = wave_sum(q);
            const float rr = 1.f / sqrtf(q * (1.f / 512.f) + LN_EPS);
            const f32x4 h0 = *(const f32x4*)(sg + lane * 8), h1 = *(const f32x4*)(sg + lane * 8 + 4);
            u32x4 wz; wz.x = cvt_pk_bf16(y[0] * rr * h0[0], y[1] * rr * h0[1]); wz.y = cvt_pk_bf16(y[2] * rr * h0[2], y[3] * rr * h0[3]);
            wz.z = cvt_pk_bf16(y[4] * rr * h1[0], y[5] * rr * h1[1]); wz.w = cvt_pk_bf16(y[6] * rr * h1[2], y[7] * rr * h1[3]);
            *(u32x4*)(mixed + (size_t)row * DM + 512 + lane * 8) = wz;
        }
      }
    }
}

#define XB_TMO      128
#define XB_XCNT(j)  (256  + 64 * (j))
#define XB_XSUB(j)  (1280 + 64 * (j))
#define XB_XGEN(j)  (2304 + 64 * (j))
#define XB_TOP      3328
#define XB_TOPGEN   3392
#define XCD_BAR_WORDS 3456
#define XB_SPIN_CAP (1u << 20)
__device__ __forceinline__ unsigned xb_ld(unsigned* p)              { return __hip_atomic_load(p, __ATOMIC_RELAXED, __HIP_MEMORY_SCOPE_AGENT); }
__device__ __forceinline__ unsigned xb_add(unsigned* p, unsigned v) { return __hip_atomic_fetch_add(p, v, __ATOMIC_RELAXED, __HIP_MEMORY_SCOPE_AGENT); }
__device__ __forceinline__ unsigned xb_xcc_id() { return (unsigned)__builtin_amdgcn_s_getreg((3 << 11) | 20) & 0xFu; }
#define XB_SPIN(cond, bar) do { unsigned _sp = 0; while (cond) { __builtin_amdgcn_s_sleep(1); \
    if ((++_sp & 255u) == 0u) { if (xb_ld(&(bar)[XB_TMO])) break; if (_sp > XB_SPIN_CAP) { atomicAdd(&(bar)[XB_TMO], 1u); break; } } } } while (0)
struct XcdBarrier { unsigned* bar; unsigned x; volatile LAS unsigned* st; unsigned total; };
__device__ __forceinline__ XcdBarrier xcd_barrier_post(unsigned* bar, volatile LAS unsigned* st, unsigned total) {
    XcdBarrier b; b.bar = bar; b.x = xb_xcc_id(); b.st = st; b.total = total;
    if (threadIdx.x == 0) (void)xb_add(&bar[XB_XCNT(b.x)], 1u);
    return b;
}
__device__ __forceinline__ void xcd_barrier_complete(unsigned* bar, unsigned x, unsigned G, unsigned& nloc, unsigned& nx) {
    unsigned sum, cnt, mine, sp = 0u;
    for (;;) {
        sum = 0u; cnt = 0u; mine = 0u;
#pragma unroll
        for (unsigned j = 0; j < 16; ++j) { const unsigned c = xb_ld(&bar[XB_XCNT(j)]); sum += c; cnt += (c > 0u) ? 1u : 0u; mine = (j == x) ? c : mine; }
        if (sum == G) break;
        __builtin_amdgcn_s_sleep(1);
        if ((++sp & 255u) == 0u) { if (xb_ld(&bar[XB_TMO])) break; if (sp > XB_SPIN_CAP) { atomicAdd(&bar[XB_TMO], 1u); break; } }
    }
    nloc = mine > 0u ? mine : 1u; nx = cnt > 0u ? cnt : 1u;
}
__device__ __forceinline__ void xcd_barrier(const XcdBarrier& b) {
    asm volatile("s_waitcnt vmcnt(0)" ::: "memory");
    __syncthreads();
    if (threadIdx.x == 0) {
        unsigned* bar = b.bar;
        __builtin_amdgcn_s_waitcnt(0);
        unsigned nloc = b.st[0], nx = b.st[1];
        if (nloc == 0u) { xcd_barrier_complete(bar, b.x, b.total, nloc, nx); b.st[0] = nloc; b.st[1] = nx; }
        const unsigned old = xb_add(&bar[XB_XSUB(b.x)], 1u);
        const unsigned gen = old / nloc;
        if (old + 1u == (gen + 1u) * nloc) {
            __builtin_amdgcn_fence(__ATOMIC_RELEASE, "agent");
            asm volatile("s_waitcnt vmcnt(0)" ::: "memory");
            const unsigned og = xb_add(&bar[XB_TOP], 1u);
            const unsigned tg = og / nx;
            if (og + 1u == (tg + 1u) * nx) xb_add(&bar[XB_TOPGEN], 1u);
            else XB_SPIN(xb_ld(&bar[XB_TOPGEN]) == tg, bar);
            __builtin_amdgcn_fence(__ATOMIC_ACQUIRE, "agent");
            xb_add(&bar[XB_XGEN(b.x)], 1u);
            asm volatile("s_waitcnt vmcnt(0)" ::: "memory");
        } else {
            XB_SPIN(xb_ld(&bar[XB_XGEN(b.x)]) == gen, bar);
            __builtin_amdgcn_fence(__ATOMIC_ACQUIRE, "agent");
            asm volatile("s_waitcnt vmcnt(0)" ::: "memory");
        }
    }
    __syncthreads();
}

__device__ __forceinline__ void sub_barrier(unsigned* cnt, unsigned target) {
    asm volatile("s_waitcnt vmcnt(0)" ::: "memory");
    __syncthreads();
    if (threadIdx.x == 0) {
        __builtin_amdgcn_fence(__ATOMIC_RELEASE, "agent");
        asm volatile("s_waitcnt vmcnt(0)" ::: "memory");
        (void)xb_add(cnt, 1u);
        unsigned sp = 0u;
        while (xb_ld(cnt) < target) { __builtin_amdgcn_s_sleep(1); if (++sp > (1u << 24)) break; }
        __builtin_amdgcn_fence(__ATOMIC_ACQUIRE, "agent");
        asm volatile("s_waitcnt vmcnt(0)" ::: "memory");
    }
    __syncthreads();
}

template <bool COOP>
__global__ void __launch_bounds__(512, 2) fwd_kernel(Args a) {
    extern __shared__ __attribute__((aligned(16))) unsigned char lds_raw[];
    LAS unsigned char* lds = (LAS unsigned char*)lds_raw;
    unsigned char* ws = a.ws;
    const int G = gridDim.x;
    const float* mod = (const float*)(ws + WS_MOD);
    bf16_t* XM = (bf16_t*)(ws + WS_XM); bf16_t* HH = (bf16_t*)(ws + WS_H);
    bf16_t* YB = (bf16_t*)a.out;
    bf16_t* Y3 = (bf16_t*)(ws + WS_Y3); f32x2n* ST1 = (f32x2n*)(ws + WS_STAT1); f32x2n* ST2 = (f32x2n*)(ws + WS_STAT2);
    const int lo = a.ph_lo, hi = a.ph_hi;
#define IN(k) (lo <= (k) && (k) < hi)
    XcdBarrier bar; bar.bar = (unsigned*)(ws + WS_BAR); bar.x = 0; bar.st = nullptr; bar.total = 0;
    if (COOP) { volatile LAS unsigned* bst = (volatile LAS unsigned*)(lds + LDS_BYTES - 16);
        if (threadIdx.x < 4) bst[threadIdx.x] = 0u;
        __syncthreads();
        bar = xcd_barrier_post((unsigned*)(ws + WS_BAR), bst, (unsigned)G); }
#define SEAM(k) do { if (COOP) { if ((k) + 1 < hi) { if ((k) == 0) cg::this_grid().sync(); else xcd_barrier(bar); } } else __syncthreads(); } while (0)
    if (IN(0)) { phase0(a, lds); SEAM(0); }
    if (IN(1)) { phase1(a, lds); SEAM(1); }
    if (IN(3)) { pg8::Gemm g{XM, (const bf16_t*)(ws + WS_WUP1), MTOK, NUP, DM, DM, DM, 1 << 20, 0}; pg8::StaticOrder S; S.init(MTOK, NUP, G, blockIdx.x);
                 pg8::EpiSwiglu E{HH}; pg8::gemm_phase(lds, g, S, E); SEAM(3); }
    if (IN(4)) { pg8::Gemm g{HH, (const bf16_t*)(ws + WS_WDN1), MTOK, DM, DFF, DFF, DFF, 1 << 20, 0}; pg8::StaticOrder S; S.init(MTOK, DM, G, blockIdx.x);
                 pg8::EpiResB<0> E{a.in[0], nullptr, nullptr, nullptr, nullptr, YB, mod + 0 * 3072 + 2048, 0.5f}; pg8::gemm_phase(lds, g, S, E); SEAM(4); }
    if (IN(5)) { row_pass_b<false>(YB, ST1, a.in[6], a.in[7], mod, 1, XM, nullptr); SEAM(5); }
    if (IN(6)) { pg8::Gemm g{XM, (const bf16_t*)(ws + WS_WIN), MTOK, NINP, DM, DM, DM, 1 << 20, 0}; pg8::StaticOrder S; S.init(MTOK, NINP, G, blockIdx.x);
                 pg8::EpiWin E{(bf16_t*)(ws + WS_QKR), (bf16_t*)(ws + WS_UEXT), (float*)(ws + WS_GATES), (const float*)(ws + WS_BIN)};
                 pg8::gemm_phase(lds, g, S, E); SEAM(6); }
    if (IN(7)) { phase_conv(a);
                 { pg8::Gemm g{(const bf16_t*)(ws + WS_UEXT), (const bf16_t*)(ws + WS_BT1), 32 * SNROW, 256, UK, UEXT, UK, SNROW / 256, (size_t)256 * UK * 2}; pg8::StaticOrder S; S.init(32 * SNROW, 256, G, blockIdx.x);
                   pg8::EpiF32 E{(float*)(ws + WS_SLOC), 256}; pg8::gemm_phase(lds, g, S, E); }
                 tbuild(a, blockIdx.x, G);
                 SEAM(7); }
    if (IN(8)) { const int half = G / 2;
                 if ((int)blockIdx.x < half) { for (int it = blockIdx.x; it < 128; it += half) { const int dir = it & 1, h = (it >> 1) & 3, b = it >> 3;
                         ml::run((const bf16_t*)(ws + WS_QKC), (const bf16_t*)(ws + WS_V), (const float*)(ws + WS_GATES), (bf16_t*)(ws + (dir ? WS_HB : WS_HF)), b, h, dir, lds); __syncthreads(); } }
                 else { const int vb = blockIdx.x - half, nB = G - half;
                     XcdBarrier barB; barB.bar = nullptr; barB.x = 0; barB.st = nullptr; barB.total = 0;
                     if (COOP) { volatile LAS unsigned* bst2 = (volatile LAS unsigned*)(lds + LDS_BYTES - 32);
                         if (threadIdx.x < 2) bst2[threadIdx.x] = 0u;
                         __syncthreads();
                         barB = xcd_barrier_post((unsigned*)(ws + WS_BAR) + 4096, bst2, (unsigned)nB); }
                     s5_scan(a, vb, nB);
                     if (COOP) xcd_barrier(barB); else __syncthreads();
                     { pg8::Gemm g{(const bf16_t*)(ws + WS_UEXT), (const bf16_t*)(ws + WS_BT2), 32 * SNROW, UK, UEXT, UEXT, UEXT, SNROW / 256, (size_t)UK * UEXT * 2}; pg8::StaticOrder S; S.init(32 * SNROW, UK, nB, vb);
                       pg8::EpiS5Out E{(bf16_t*)(ws + WS_YACT)}; pg8::gemm_phase(lds, g, S, E); }
                     if (COOP) xcd_barrier(barB); else __syncthreads();
                     { pg8::Gemm g{(const bf16_t*)(ws + WS_YACT), (const bf16_t*)(ws + WS_WGLU), MTOK, 512, 512, 512, 512, 1 << 20, 0}; pg8::StaticOrder S; S.init(MTOK, 512, nB, vb);
                       pg8::EpiGlu E{(const bf16_t*)(ws + WS_YACT), (bf16_t*)(ws + WS_Z), a.in[22]}; pg8::gemm_phase(lds, g, S, E); }
                     if (COOP) xcd_barrier(barB); else __syncthreads();
                     phase_mixfin<1>(a, vb, nB); }
                 SEAM(8); }
    if (IN(11)) { phase_mixfin<0>(a, blockIdx.x, G); SEAM(11); }
    if (IN(12)) { pg8::Gemm g{XM, (const bf16_t*)(ws + WS_WOUT), MTOK, DM, DM, DM, DM, 1 << 20, 0}; pg8::StaticOrder S; S.init(MTOK, DM, G, blockIdx.x);
                 pg8::EpiResB<1> E{nullptr, YB, ST1, a.in[6], a.in[7], YB, mod + 1 * 3072 + 2048, 1.0f}; pg8::gemm_phase(lds, g, S, E); SEAM(12); }
    if (IN(13)) { row_pass_b<false>(YB, ST2, a.in[25], a.in[26], mod, 2, XM, nullptr); SEAM(13); }
    if (IN(14)) { pg8::Gemm g{XM, (const bf16_t*)(ws + WS_WUP2), MTOK, NUP, DM, DM, DM, 1 << 20, 0}; pg8::StaticOrder S; S.init(MTOK, NUP, G, blockIdx.x);
                 pg8::EpiSwiglu E{HH}; pg8::gemm_phase(lds, g, S, E); SEAM(14); }
    if (IN(15)) { pg8::Gemm g{HH, (const bf16_t*)(ws + WS_WDN2), MTOK, DM, DFF, DFF, DFF, 1 << 20, 0}; pg8::StaticOrder S; S.init(MTOK, DM, G, blockIdx.x);
                 pg8::EpiResB<1> E{nullptr, YB, ST2, a.in[25], a.in[26], Y3, mod + 2 * 3072 + 2048, 0.5f}; pg8::gemm_phase(lds, g, S, E); SEAM(15); }
    if (IN(16)) { row_pass_b<true>(Y3, nullptr, a.in[29], a.in[30], nullptr, 0, nullptr, a.out); }
#undef IN
#undef SEAM
}

#ifndef MK_ONE_LAUNCH
#define MK_ONE_LAUNCH 1
#endif
extern "C" void kernel_launch(void* const* d_in, const int* in_sizes, int n_in, void* d_out, int out_size, void* d_ws, size_t ws_size, hipStream_t stream) {
    static int grid = 0;
    if (grid == 0) {
        if (n_in != 31 || out_size != MTOK * DM || ws_size < WS_END) { fprintf(stderr, "kernel_launch: unexpected shapes (n_in %d out %d ws %zu)\n", n_in, out_size, ws_size); grid = -1; return; }
        int dev = 0, cus = 0, per_cu = 0;
        (void)hipGetDevice(&dev); (void)hipDeviceGetAttribute(&cus, hipDeviceAttributeMultiprocessorCount, dev);
        (void)hipFuncSetAttribute((const void*)fwd_kernel<true>, hipFuncAttributeMaxDynamicSharedMemorySize, LDS_BYTES);
        (void)hipFuncSetAttribute((const void*)fwd_kernel<false>, hipFuncAttributeMaxDynamicSharedMemorySize, LDS_BYTES);
        (void)hipOccupancyMaxActiveBlocksPerMultiprocessor(&per_cu, (const void*)fwd_kernel<true>, 512, LDS_BYTES);
        if (per_cu < 1) { fprintf(stderr, "kernel_launch: occupancy query says %d blocks per CU\n", per_cu); per_cu = 1; }
        (void)hipGetLastError();
        grid = cus * per_cu;
    }
    if (grid < 0) return;
    Args a{};
    for (int i = 0; i < 31; ++i) a.in[i] = (const float*)d_in[i];
    a.out = (float*)d_out; a.ws = (unsigned char*)d_ws;
#if MK_ONE_LAUNCH
    (void)hipMemsetAsync((char*)d_ws + WS_BAR, 0, BAR_BYTES, stream);
    a.ph_lo = 0; a.ph_hi = NPHASE;
    void* args[] = {&a};
    hipError_t e = hipLaunchCooperativeKernel((const void*)fwd_kernel<true>, dim3(grid), dim3(512), args, LDS_BYTES, stream);
    if (e != hipSuccess) fprintf(stderr, "cooperative launch failed: %s (grid %d)\n", hipGetErrorString(e), grid);
#else
    for (int ph = 0; ph < NPHASE; ++ph) { a.ph_lo = ph; a.ph_hi = ph + 1; hipLaunchKernelGGL(fwd_kernel<false>, dim3(grid), dim3(512), LDS_BYTES, stream, a); }
#endif
}
```
